# Optimizing an MI355X kernel written in HIP

```python
import jax
import jax.numpy as jnp
from jax import lax
import numpy as np

D_MODEL = 2048
BATCH = 8
SEQ = 2048
DEPTH = 1

NORM_EPS = 1e-5
ROPE_THETA = 10000.0
NEG_INF = -1e30

NSA_HEADS = 8
NSA_KV_GROUPS = 2
NSA_HPG = NSA_HEADS // NSA_KV_GROUPS
NSA_HEAD_DIM = 128
CMP_LEN = 32
CMP_STRIDE = 16
CMP_HIDDEN = 256
SEL_LEN = 64
SEL_TOPK = 16
SEL_QBLOCK = 32
SEL_FORCE = 1e3
WINDOW = 512
WIN_QBLOCK = 128

GLA_HEADS = 4
GLA_DK = 128
GLA_DV = 256
GLA_GATE_RANK = 16
GLA_TAU = 16.0
GLA_CHUNK = 64

N_EXPERTS = 32
TOP_K = 4
MOE_FF = D_MODEL
SWIGLU_LIMIT = 7.0
SWIGLU_ALPHA = 1.702
MOE_BLOCK = 256

NSA_Q = NSA_HEADS * NSA_HEAD_DIM
NSA_KV = NSA_KV_GROUPS * NSA_HEAD_DIM
GLA_QK = GLA_HEADS * GLA_DK
GLA_V = GLA_HEADS * GLA_DV
IN_SPLITS = (NSA_Q, 6 * NSA_KV, 3 * NSA_HEADS, GLA_QK, GLA_QK, GLA_V, GLA_V, GLA_GATE_RANK)
IN_WIDTH = NSA_Q + 6 * NSA_KV + 3 * NSA_HEADS + 2 * GLA_QK + 2 * GLA_V + GLA_GATE_RANK

kernel_name = 'hybrid_nsa_gla_moe_block'


def rms_norm(x, gain):
    xf = x.astype(jnp.float32)
    y = xf * lax.rsqrt(jnp.mean(xf * xf, axis=-1, keepdims=True) + NORM_EPS)
    return (y * gain.astype(jnp.float32)).astype(x.dtype)


def split_cols(t, sizes):
    out, off = [], 0
    for n in sizes:
        out.append(t[..., off:off + n])
        off += n
    return out


def rope(x, pos):
    half = x.shape[-1] // 2
    inv_freq = ROPE_THETA ** (-jnp.arange(half, dtype=jnp.float32) / half)
    ang = pos.astype(jnp.float32)[:, None] * inv_freq[None, :]
    shape = (1, pos.shape[0]) + (1,) * (x.ndim - 3) + (half,)
    cos = jnp.cos(ang).reshape(shape)
    sin = jnp.sin(ang).reshape(shape)
    xf = x.astype(jnp.float32)
    x1, x2 = xf[..., :half], xf[..., half:]
    return jnp.concatenate([x1 * cos - x2 * sin, x2 * cos + x1 * sin], axis=-1).astype(x.dtype)


def masked_softmax(s, mask, axis=-1):
    s = jnp.where(mask, s.astype(jnp.float32), NEG_INF)
    return jnp.where(mask, jax.nn.softmax(s, axis=axis), 0.0)


def compress_kv(kv, pos_emb, w1, w2):
    b, s, g, dh = kv.shape
    n_cmp = (s - CMP_LEN) // CMP_STRIDE + 1
    idx = jnp.arange(n_cmp)[:, None] * CMP_STRIDE + jnp.arange(CMP_LEN)[None, :]
    blocks = kv[:, idx] + pos_emb[None, None, :, None, :]
    flat = blocks.transpose(0, 1, 3, 2, 4).reshape(b, n_cmp, g, CMP_LEN * dh)
    return jax.nn.gelu(flat @ w1) @ w2


def nsa_attention(q, kv, gate_logits, cmp_pos_k, cmp_pos_v, w_ck1, w_ck2, w_cv1, w_cv2):
    b, s = q.shape[:2]
    dt = q.dtype
    G, HPG, DH = NSA_KV_GROUPS, NSA_HPG, NSA_HEAD_DIM
    scale = DH ** -0.5
    pos = jnp.arange(s)
    qg = q.reshape(b, s, G, HPG, DH)
    k_c, v_c, k_s, v_s, k_w, v_w = [t.reshape(b, s, G, DH) for t in jnp.split(kv, 6, axis=-1)]

    k_cmp = compress_kv(k_c, cmp_pos_k, w_ck1, w_ck2)
    v_cmp = compress_kv(v_c, cmp_pos_v, w_cv1, w_cv2)
    n_cmp = k_cmp.shape[1]
    cmp_start = jnp.arange(n_cmp) * CMP_STRIDE
    cmp_mask = (cmp_start + CMP_LEN - 1)[None, :] <= pos[:, None]
    s_cmp = jnp.einsum('bsghd,bngd->bghsn', qg, k_cmp).astype(jnp.float32) * scale
    p_cmp = masked_softmax(s_cmp, cmp_mask)
    o_cmp = jnp.einsum('bghsn,bngd->bsghd', p_cmp.astype(dt), v_cmp)

    n_blk = s // SEL_LEN
    n_sel = min(SEL_TOPK, n_blk)
    blk = jnp.arange(n_blk)
    cover = ((cmp_start[:, None] < (blk[None, :] + 1) * SEL_LEN)
             & (cmp_start[:, None] + CMP_LEN > blk[None, :] * SEL_LEN)).astype(jnp.float32)
    importance = jnp.einsum('bghsn,nj->bgsj', p_cmp, cover)
    t_blk = (pos // SEL_LEN)[:, None]
    forced = (blk[None, :] == 0) | (blk[None, :] == t_blk) | (blk[None, :] == t_blk - 1)
    bonus = jnp.where(blk[None, :] > t_blk, -SEL_FORCE, jnp.where(forced, SEL_FORCE, 0.0))
    _, sel_idx = lax.top_k(importance + bonus, n_sel)

    q_r = rope(qg, pos)
    k_sr = rope(k_s, pos)
    k_wr = rope(k_w, pos)
    k_blocks = k_sr.reshape(b, n_blk, SEL_LEN, G, DH).transpose(0, 3, 1, 2, 4)
    v_blocks = v_s.reshape(b, n_blk, SEL_LEN, G, DH).transpose(0, 3, 1, 2, 4)
    nqb = s // SEL_QBLOCK
    q_blk = q_r.reshape(b, nqb, SEL_QBLOCK, G, HPG, DH).transpose(1, 0, 3, 2, 4, 5)
    i_blk = sel_idx.reshape(b, G, nqb, SEL_QBLOCK, n_sel).transpose(2, 0, 1, 3, 4)
    t_q = pos.reshape(nqb, SEL_QBLOCK)
    b_ix = jnp.arange(b)[:, None, None, None]
    g_ix = jnp.arange(G)[None, :, None, None]

    def sel_block(args):
        qb, ib, tq = args
        kg = k_blocks[b_ix, g_ix, ib]
        vg = v_blocks[b_ix, g_ix, ib]
        sc = jnp.einsum('bgqhd,bgqnld->bgqhnl', qb, kg).astype(jnp.float32) * scale
        kpos = ib[..., None] * SEL_LEN + jnp.arange(SEL_LEN)
        mask = (kpos <= tq[None, None, :, None, None])[:, :, :, None]
        p = masked_softmax(sc, mask, axis=(-2, -1))
        return jnp.einsum('bgqhnl,bgqnld->bgqhd', p.astype(dt), vg)

    o_sel = lax.map(sel_block, (q_blk, i_blk, t_q))
    o_sel = o_sel.transpose(1, 0, 3, 2, 4, 5).reshape(b, s, G, HPG, DH)

    nwb = s // WIN_QBLOCK
    span = WIN_QBLOCK + WINDOW
    k_pad = jnp.pad(k_wr, ((0, 0), (WINDOW, 0), (0, 0), (0, 0)))
    v_pad = jnp.pad(v_w, ((0, 0), (WINDOW, 0), (0, 0), (0, 0)))
    kidx = jnp.arange(nwb)[:, None] * WIN_QBLOCK + jnp.arange(span)[None, :]
    k_win = k_pad[:, kidx]
    v_win = v_pad[:, kidx]
    q_win = q_r.reshape(b, nwb, WIN_QBLOCK, G, HPG, DH)
    sc = jnp.einsum('bnqghd,bnkgd->bnghqk', q_win, k_win).astype(jnp.float32) * scale
    k_real = (kidx - WINDOW)[:, None, :]
    tq = pos.reshape(nwb, WIN_QBLOCK)[:, :, None]
    wmask = (k_real <= tq) & (k_real > tq - WINDOW) & (k_real >= 0)
    p = masked_softmax(sc, wmask[None, :, None, None])
    o_win = jnp.einsum('bnghqk,bnkgd->bnqghd', p.astype(dt), v_win).reshape(b, s, G, HPG, DH)

    g = jax.nn.sigmoid(gate_logits).reshape(b, s, G, HPG, 3)
    o = g[..., 0:1] * o_cmp + g[..., 1:2] * o_sel + g[..., 2:3] * o_win
    return o.reshape(b, s, NSA_Q)


def gla_attention(q, k, v, r, a_lr, w_alpha, b_alpha, norm_gain):
    b, s = q.shape[:2]
    dt = q.dtype
    H, C = GLA_HEADS, GLA_CHUNK
    nc = s // C
    log_a = jax.nn.log_sigmoid((a_lr @ w_alpha + b_alpha).astype(jnp.float32)) / GLA_TAU

    def chunks(t, d):
        return t.astype(jnp.float32).reshape(b, nc, C, H, d)

    qc = chunks(q, GLA_DK) * (GLA_DK ** -0.5)
    kc = chunks(k, GLA_DK)
    vc = chunks(v, GLA_DV)
    cum = jnp.cumsum(chunks(log_a, GLA_DK), axis=2)
    cum_last = cum[:, :, -1]
    q_t = qc * jnp.exp(cum)
    k_t = kc * jnp.exp(-cum)
    causal = jnp.tril(jnp.ones((C, C), dtype=bool))
    attn = jnp.where(causal, jnp.einsum('bnihd,bnjhd->bnhij', q_t, k_t), 0.0)
    o_intra = jnp.einsum('bnhij,bnjhv->bnihv', attn, vc)
    k_state = kc * jnp.exp(cum_last[:, :, None] - cum)
    d_state = jnp.einsum('bnchd,bnchv->nbhdv', k_state, vc)
    decay = jnp.exp(cum_last).transpose(1, 0, 2, 3)

    def step(state, inp):
        dec, ds = inp
        return dec[..., None] * state + ds, state

    state0 = jnp.zeros((b, H, GLA_DK, GLA_DV), jnp.float32)
    _, prev_states = lax.scan(step, state0, (decay, d_state))
    o_inter = jnp.einsum('bnihd,nbhdv->bnihv', q_t, prev_states)
    o = (o_intra + o_inter).reshape(b, s, H, GLA_DV)
    o = o * lax.rsqrt(jnp.mean(o * o, axis=-1, keepdims=True) + NORM_EPS)
    o = o.reshape(b, s, GLA_V) * norm_gain.astype(jnp.float32)
    return (o * jax.nn.silu(r.astype(jnp.float32))).astype(dt)


def moe_ffn(h, w_router, b_router, w_gate_up, b_gate_up, w_down, b_down):
    b, s, d = h.shape
    n = b * s
    nk = n * TOP_K
    hf = h.reshape(n, d)
    logits = (hf @ w_router + b_router).astype(jnp.float32)
    top_v, top_e = lax.top_k(logits, TOP_K)
    top_w = jax.nn.softmax(top_v, axis=-1)
    flat_e = top_e.reshape(nk)
    flat_tok = jnp.arange(nk) // TOP_K
    flat_w = top_w.reshape(nk)
    order = jnp.argsort(flat_e)
    se = flat_e[order]
    counts = jnp.bincount(flat_e, length=N_EXPERTS)
    padded = (counts + MOE_BLOCK - 1) // MOE_BLOCK * MOE_BLOCK
    pad_end = jnp.cumsum(padded)
    pad_start = pad_end - padded
    start = jnp.cumsum(counts) - counts
    dest = pad_start[se] + jnp.arange(nk) - start[se]
    n_blocks = -(-nk // MOE_BLOCK) + N_EXPERTS
    n_slots = n_blocks * MOE_BLOCK
    slot_tok = jnp.zeros((n_slots,), jnp.int32).at[dest].set(flat_tok[order])
    slot_w = jnp.zeros((n_slots,), jnp.float32).at[dest].set(flat_w[order])
    blk_e = jnp.minimum(jnp.searchsorted(pad_end, jnp.arange(n_blocks) * MOE_BLOCK, side='right'), N_EXPERTS - 1)

    def expert_block(y, args):
        e, tok, wt = args
        xb = hf[tok]
        gu = xb @ w_gate_up[e] + b_gate_up[e]
        gate = jnp.minimum(gu[:, :MOE_FF], SWIGLU_LIMIT)
        up = jnp.clip(gu[:, MOE_FF:], -SWIGLU_LIMIT, SWIGLU_LIMIT)
        act = (up + 1.0) * gate * jax.nn.sigmoid(gate * SWIGLU_ALPHA)
        out = act @ w_down[e] + b_down[e]
        return y.at[tok].add(out.astype(jnp.float32) * wt[:, None]), None

    y, _ = lax.scan(expert_block, jnp.zeros((n, d), jnp.float32),
                    (blk_e, slot_tok.reshape(n_blocks, MOE_BLOCK), slot_w.reshape(n_blocks, MOE_BLOCK)))
    return y.astype(h.dtype).reshape(b, s, d)


def setup_inputs(seed: int = 0) -> dict:
    key = jax.random.key(seed)
    ks = jax.random.split(key, 26)
    L, D, E, F = DEPTH, D_MODEL, N_EXPERTS, MOE_FF

    def nrm(k, shape, scale):
        return jax.random.normal(k, shape, jnp.float32) * scale

    return {
        'x': nrm(ks[0], (BATCH, SEQ, D), 1.0),
        'norm_mix': 1.0 + nrm(ks[1], (L, D), 0.02),
        'w_in': nrm(ks[2], (L, D, IN_WIDTH), D ** -0.5),
        'cmp_pos_k': nrm(ks[3], (L, CMP_LEN, NSA_HEAD_DIM), 0.1),
        'cmp_pos_v': nrm(ks[4], (L, CMP_LEN, NSA_HEAD_DIM), 0.1),
        'w_cmp_k1': nrm(ks[5], (L, CMP_LEN * NSA_HEAD_DIM, CMP_HIDDEN), (CMP_LEN * NSA_HEAD_DIM) ** -0.5),
        'w_cmp_k2': nrm(ks[6], (L, CMP_HIDDEN, NSA_HEAD_DIM), CMP_HIDDEN ** -0.5),
        'w_cmp_v1': nrm(ks[7], (L, CMP_LEN * NSA_HEAD_DIM, CMP_HIDDEN), (CMP_LEN * NSA_HEAD_DIM) ** -0.5),
        'w_cmp_v2': nrm(ks[8], (L, CMP_HIDDEN, NSA_HEAD_DIM), CMP_HIDDEN ** -0.5),
        'w_gla_alpha': nrm(ks[9], (L, GLA_GATE_RANK, GLA_QK), GLA_GATE_RANK ** -0.5),
        'b_gla_alpha': nrm(ks[10], (L, GLA_QK), 0.1),
        'gla_norm': 1.0 + nrm(ks[11], (L, GLA_V), 0.02),
        'w_proj_nsa': nrm(ks[12], (L, NSA_Q, D), NSA_Q ** -0.5),
        'w_proj_gla': nrm(ks[13], (L, GLA_V, D), GLA_V ** -0.5),
        'w_merge_gate': nrm(ks[14], (L, D, 2 * D), D ** -0.5),
        'b_merge_gate': nrm(ks[15], (L, 2 * D), 0.1),
        'w_out': nrm(ks[16], (L, D, D), D ** -0.5),
        'norm_moe': 1.0 + nrm(ks[17], (L, D), 0.02),
        'w_router': nrm(ks[18], (L, D, E), D ** -0.5),
        'b_router': nrm(ks[19], (L, E), 0.01),
        'w_gate_up': nrm(ks[20], (L, E, D, 2 * F), D ** -0.5),
        'b_gate_up': nrm(ks[21], (L, E, 2 * F), 0.01),
        'w_down': nrm(ks[22], (L, E, F, D), F ** -0.5),
        'b_down': nrm(ks[23], (L, E, D), 0.01),
        'norm_final': 1.0 + nrm(ks[24], (D,), 0.02),
    }


def reference(x, norm_mix, w_in, cmp_pos_k, cmp_pos_v, w_cmp_k1, w_cmp_k2, w_cmp_v1, w_cmp_v2,
              w_gla_alpha, b_gla_alpha, gla_norm, w_proj_nsa, w_proj_gla, w_merge_gate, b_merge_gate,
              w_out, norm_moe, w_router, b_router, w_gate_up, b_gate_up, w_down, b_down, norm_final):
    for l in range(DEPTH):
        h = rms_norm(x, norm_mix[l])
        q_n, kv_n, g_n, q_g, k_g, v_g, r_g, a_g = split_cols(h @ w_in[l], IN_SPLITS)
        o_nsa = nsa_attention(q_n, kv_n, g_n, cmp_pos_k[l], cmp_pos_v[l],
                              w_cmp_k1[l], w_cmp_k2[l], w_cmp_v1[l], w_cmp_v2[l])
        o_gla = gla_attention(q_g, k_g, v_g, r_g, a_g, w_gla_alpha[l], b_gla_alpha[l], gla_norm[l])
        merge = jax.nn.sigmoid(h @ w_merge_gate[l] + b_merge_gate[l])
        mixed = (merge[..., :D_MODEL] * (o_nsa @ w_proj_nsa[l])
                 + merge[..., D_MODEL:] * (o_gla @ w_proj_gla[l]))
        x = x + mixed @ w_out[l]
        x = x + moe_ffn(rms_norm(x, norm_moe[l]), w_router[l], b_router[l],
                        w_gate_up[l], b_gate_up[l], w_down[l], b_down[l])
    return rms_norm(x, norm_final)
```

```cpp
#include <hip/hip_runtime.h>
#define SPLIT_CONV 24
#define SPLIT_TAIL 384
#include <cstdio>
#include <cstdint>
#include <cmath>

#define LAS __attribute__((address_space(3)))
#define GAS __attribute__((address_space(1)))
typedef unsigned short bf16_t;
typedef short bf16x8 __attribute__((ext_vector_type(8)));
typedef short s16x4 __attribute__((ext_vector_type(4)));
typedef float f32x2 __attribute__((ext_vector_type(2)));
typedef float f32x4 __attribute__((ext_vector_type(4)));
typedef float f32x16 __attribute__((ext_vector_type(16)));
typedef unsigned u32x2 __attribute__((ext_vector_type(2)));
typedef unsigned u32x4 __attribute__((ext_vector_type(4)));
#define DI __device__ __forceinline__
#define LDS_BARRIER() do { asm volatile("s_waitcnt lgkmcnt(0)" ::: "memory"); __builtin_amdgcn_s_barrier(); asm volatile("" ::: "memory"); } while (0)

constexpr int NB = 8, SEQ = 2048, DM = 2048, NTOK = NB * SEQ;
constexpr int NSA_H = 8, NSA_G = 2, HPG = 4, DH = 128;
constexpr int NCMP = 127, CMP_HID = 256;
constexpr int GLA_H = 4, GDK = 128, GDV = 256, GCH = 64, GNC = SEQ / GCH;
constexpr int NEXP = 32, FF = 2048, ECAP = NTOK;
constexpr int IN_W = 5672;
constexpr int OFF_QN = 0, OFF_KV = 1024, OFF_GN = 2560, OFF_QG = 2584, OFF_KG = 3096, OFF_VG = 3608, OFF_RG = 4632, OFF_AG = 5656;
constexpr int N1_TILES = 39, N1 = N1_TILES * 256, N1A_TILES = 23, N1B_TILES = 16;
constexpr float NORM_EPS = 1e-5f;

constexpr size_t MiB = 1u << 20;
constexpr size_t WS_CTL = 0, CTL_ZERO_BYTES = 1 * MiB;
constexpr size_t WS_TAB = 1 * MiB;
constexpr size_t WS_CBIAS = 2 * MiB;
constexpr size_t WS_WRT = 2 * MiB + 65536;
constexpr size_t WS_WT1 = 4 * MiB;
constexpr size_t WS_WPN = 44 * MiB;
constexpr size_t WS_WOUT = 52 * MiB, WS_WCK1 = 60 * MiB, WS_WCV1 = 62 * MiB;
constexpr size_t WS_HN = 64 * MiB;
constexpr size_t WS_QRAW = 128 * MiB;
constexpr size_t WS_KV = 192 * MiB, KV_STRIDE = 8 * MiB;
constexpr size_t WS_QG = 240 * MiB, WS_KG = 256 * MiB, WS_VG = 272 * MiB, WS_RG = 304 * MiB;
constexpr size_t WS_SMALL = 336 * MiB;
constexpr size_t WS_MG = 340 * MiB;
constexpr size_t WS_ONSA = 468 * MiB;
constexpr size_t WS_MIXED = 660 * MiB;
constexpr size_t WS_X2 = 724 * MiB;
constexpr size_t WS_HN2 = 852 * MiB;
constexpr size_t WS_CPART = 916 * MiB;
constexpr size_t WS_KCMP = 980 * MiB;
constexpr size_t WS_GQT = 982 * MiB, WS_GKS = 1014 * MiB;
constexpr size_t WS_GATT = 1030 * MiB;
constexpr size_t WS_GDEC = 1038 * MiB;
constexpr size_t WS_GO = 1040 * MiB;
constexpr size_t WS_STOK = 1104 * MiB;
constexpr size_t WS_TREC = 1106 * MiB;
constexpr size_t WS_ACT = 1112 * MiB;
constexpr size_t WS_EO = 1400 * MiB;
constexpr size_t WS_WGU = 1688 * MiB;
constexpr size_t WS_WDN = 2200 * MiB;
constexpr size_t WS_HN8 = 1944 * MiB;
constexpr size_t WS_WT1B = 1976 * MiB;
constexpr size_t WS_SSQP = 2064 * MiB;
constexpr size_t WS_END = 2456 * MiB;
constexpr int CW_BAR = 4096, CW_CNT = 8192;

constexpr int RING_BYTES = 131072;
constexpr int LDS_TAB = RING_BYTES;
constexpr int LDS_MISC = RING_BYTES + 8192;
constexpr int LDS_BYTES = 147456;

typedef __bf16 bf16x2_t __attribute__((ext_vector_type(2)));
DI unsigned cvt_pk_bf16(float lo, float hi) { const f32x2 v = {lo, hi}; return __builtin_bit_cast(unsigned, __builtin_convertvector(v, bf16x2_t)); }
DI float bf2f(bf16_t b) { return __uint_as_float(((unsigned)b) << 16); }
DI float bflo(unsigned w) { return __uint_as_float(w << 16); }
DI float bfhi(unsigned w) { return __uint_as_float(w & 0xffff0000u); }
DI bf16_t f2bf(float f) { return (bf16_t)(cvt_pk_bf16(f, 0.f) & 0xffffu); }
constexpr float W8_SCALE = 64.0f, W8_INV = 1.0f / 64.0f;
DI unsigned pk4_fp8(float a, float b, float c, float d) { int w = 0; w = __builtin_amdgcn_cvt_pk_fp8_f32(a, b, w, false); w = __builtin_amdgcn_cvt_pk_fp8_f32(c, d, w, true); return (unsigned)w; }
DI float wave_sum(float v) {
#pragma unroll
    for (int o = 32; o > 0; o >>= 1) v += __shfl_xor(v, o);
    return v;
}
DI float fast_sigmoid(float x) { return __builtin_amdgcn_rcpf(1.0f + __builtin_amdgcn_exp2f(-1.4426950408889634f * x)); }

#define XB_TMO      128
#define XB_XCNT(j)  (256  + 64 * (j))
#define XB_XSUB(j)  (1280 + 64 * (j))
#define XB_XGEN(j)  (2304 + 64 * (j))
#define XB_TOP      3328
#define XB_TOPGEN   3392
#define XCD_BAR_WORDS 3456
#define XB_SPIN_CAP (1u << 18)

__device__ __forceinline__ unsigned xb_ld(unsigned* p)              { return __hip_atomic_load(p, __ATOMIC_RELAXED, __HIP_MEMORY_SCOPE_AGENT); }
__device__ __forceinline__ unsigned xb_add(unsigned* p, unsigned v) { return __hip_atomic_fetch_add(p, v, __ATOMIC_RELAXED, __HIP_MEMORY_SCOPE_AGENT); }
__device__ __forceinline__ unsigned xb_xcc_id() { return (unsigned)__builtin_amdgcn_s_getreg((3 << 11) | 20) & 0xFu; }
#define XB_SPIN(cond, bar) do { unsigned _sp = 0; while (cond) { __builtin_amdgcn_s_sleep(1); \
    if ((++_sp & 255u) == 0u) { if (xb_ld(&(bar)[XB_TMO])) break; if (_sp > XB_SPIN_CAP) { atomicAdd(&(bar)[XB_TMO], 1u); break; } } } } while (0)

struct XcdBarrier { unsigned* bar; unsigned x; volatile LAS unsigned* st; };

__device__ __forceinline__ XcdBarrier xcd_barrier_post(unsigned* bar, volatile LAS unsigned* st) {
    XcdBarrier b; b.bar = bar; b.x = xb_xcc_id(); b.st = st;
    if (threadIdx.x == 0) (void)xb_add(&bar[XB_XCNT(b.x)], 1u);
    return b;
}
__device__ __forceinline__ void xcd_barrier_complete(unsigned* bar, unsigned x, unsigned& nloc, unsigned& nx) {
    const unsigned G = gridDim.x * gridDim.y * gridDim.z;
    unsigned sum, cnt, mine, sp = 0u;
    for (;;) {
        sum = 0u; cnt = 0u; mine = 0u;
#pragma unroll
        for (unsigned j = 0; j < 16; ++j) { const unsigned c = xb_ld(&bar[XB_XCNT(j)]); sum += c; cnt += (c > 0u) ? 1u : 0u; mine = (j == x) ? c : mine; }
        if (sum == G) break;
        __builtin_amdgcn_s_sleep(1);
        if ((++sp & 255u) == 0u) { if (xb_ld(&bar[XB_TMO])) break; if (sp > XB_SPIN_CAP) { atomicAdd(&bar[XB_TMO], 1u); break; } }
    }
    nloc = mine > 0u ? mine : 1u; nx = cnt > 0u ? cnt : 1u;
}
__device__ __forceinline__ void xcd_barrier(const XcdBarrier& b) {
    asm volatile("s_waitcnt vmcnt(0)" ::: "memory");
    __syncthreads();
    if (threadIdx.x == 0) {
        unsigned* bar = b.bar;
        __builtin_amdgcn_s_waitcnt(0);
        unsigned nloc = b.st[0], nx = b.st[1];
        if (nloc == 0u) { xcd_barrier_complete(bar, b.x, nloc, nx); b.st[0] = nloc; b.st[1] = nx; }
        const unsigned old = xb_add(&bar[XB_XSUB(b.x)], 1u);
        const unsigned gen = old / nloc;
        if (old + 1u == (gen + 1u) * nloc) {
            __builtin_amdgcn_fence(__ATOMIC_RELEASE, "agent");
            asm volatile("s_waitcnt vmcnt(0)" ::: "memory");
            const unsigned og = xb_add(&bar[XB_TOP], 1u);
            const unsigned tg = og / nx;
            if (og + 1u == (tg + 1u) * nx) xb_add(&bar[XB_TOPGEN], 1u);
            else XB_SPIN(xb_ld(&bar[XB_TOPGEN]) == tg, bar);
            __builtin_amdgcn_fence(__ATOMIC_ACQUIRE, "agent");
            xb_add(&bar[XB_XGEN(b.x)], 1u);
            asm volatile("s_waitcnt vmcnt(0)" ::: "memory");
        } else {
            XB_SPIN(xb_ld(&bar[XB_XGEN(b.x)]) == gen, bar);
            __builtin_amdgcn_fence(__ATOMIC_ACQUIRE, "agent");
            asm volatile("s_waitcnt vmcnt(0)" ::: "memory");
        }
    }
    __syncthreads();
}
namespace pg8 {
constexpr int BM = 256, BK = 64, HALF = 128, HTB = HALF * BK * 2, STAGE_BYTES = 8 * HTB, NXCD = 8, WGM = 8;
__host__ __device__ __forceinline__ int lds_byte(int r, int c) { const int st = (r >> 4) * 2 + (c >> 5), rr = r & 15, cc = c & 31, ob = rr * 64 + cc * 2; return st * 1024 + (ob ^ (((ob >> 9) & 1) << 5)); }
__host__ __device__ __forceinline__ void stage_rc(int b, int& R, int& C) { const int st = b / 1024, sb = b % 1024, swz = sb ^ (((sb >> 9) & 1) << 5); R = (st >> 1) * 16 + swz / 64; C = (st & 1) * 32 + (swz % 64) / 2; }
__host__ __device__ __forceinline__ int perm32(int rho) { const int n = rho >> 4, i = rho & 15; return 8 * (i >> 2) + 4 * n + (i & 3); }

struct Unit { const char* A; const char* B; int pm, pn, aux, rows, keep, par; };

DI bool static_tile(int i, int G, int c, int nM, int nN, int& pm, int& pn) {
    const int nwg = nM * nN; const long L = (long)i * G + c; if (L >= nwg) return false;
    int wgid = (int)L; { const int q = nwg / NXCD, r = nwg % NXCD, xcd = wgid % NXCD, off = wgid / NXCD; wgid = (xcd < r ? xcd * (q + 1) : r * (q + 1) + (xcd - r) * q) + off; }
    const int nig = WGM * nN, gid = wgid / nig, fm = gid * WGM, gsz = (nM - fm) < WGM ? (nM - fm) : WGM;
    pm = fm + ((wgid % nig) % gsz); pn = (wgid % nig) / gsz; return true;
}

DI bool static_tile_lin(long L, int nM, int nN, int& pm, int& pn) {
    const int nwg = nM * nN; if (L >= nwg) return false;
    int wgid = (int)L; { const int q = nwg / NXCD, r = nwg % NXCD, xcd = wgid % NXCD, off = wgid / NXCD; wgid = (xcd < r ? xcd * (q + 1) : r * (q + 1) + (xcd - r) * q) + off; }
    const int nig = WGM * nN, gid = wgid / nig, fm = gid * WGM, gsz = (nM - fm) < WGM ? (nM - fm) : WGM;
    pm = fm + ((wgid % nig) % gsz); pn = (wgid % nig) / gsz; return true;
}

constexpr int PRE_OFF = 131072 + 8192 + 1024;
template <class E> struct has_pre { template <class T> static constexpr bool f(decltype(T::PRE)*) { return T::PRE; } template <class T> static constexpr bool f(...) { return false; } static constexpr bool value = f<E>(nullptr); };
typedef int i32x8 __attribute__((ext_vector_type(8)));
template <bool FP8, class Epi, class Sched>
DI void gemm_phase(LAS unsigned char* lds, const int K, const unsigned ldb, const Sched& S, const Epi& E) {
    int tid = threadIdx.x; asm volatile("" : "+v"(tid));
    const int wid = __builtin_amdgcn_readfirstlane(tid >> 6), lane = tid & 63, wr = wid >> 2, wc = wid & 3, fr = lane & 15, fq = lane >> 4;
    const int nt = K / BK;
    int R[2], C[2]; unsigned voffB[2];
#pragma unroll
    for (int i = 0; i < 2; ++i) { stage_rc(tid * 16 + i * 8192, R[i], C[i]); const int Rb = (R[i] & ~31) + perm32(R[i] & 31); voffB[i] = (unsigned)Rb * ldb + (unsigned)C[i] * 2u; }
    const size_t kstep = (size_t)(BK * 2);
    const size_t hstepB = (size_t)HALF * ldb;
    const unsigned ldsw = (unsigned)wid * 1024u;
    const int aoff = lds_byte(wr * 64 + fr, fq * 8), boff = lds_byte(wc * 32 + fr, fq * 8);
#define PG8_SA(b, h) (((b) * 2 + (h)) * HTB)
#define PG8_SB(b, h) ((4 + (b) * 2 + (h)) * HTB)
#define PG8_STAGE_B(bufoff, gbase) do { _Pragma("unroll") for (int _i = 0; _i < 2; ++_i) \
        __builtin_amdgcn_global_load_lds((const unsigned*)((const char*)(gbase) + voffB[_i]), (LAS unsigned*)(lds + (bufoff) + ldsw + _i * 8192), 16, 0, 0); } while (0)
#define PG8_STAGE_A(bufoff, gbase, v, h) do { _Pragma("unroll") for (int _i = 0; _i < 2; ++_i) \
        __builtin_amdgcn_global_load_lds((const unsigned*)((const char*)(gbase) + (v)[(h) * 2 + _i]), (LAS unsigned*)(lds + (bufoff) + ldsw + _i * 8192), 16, 0, 0); } while (0)
#define PG8_LDA(dst, b, h) do { _Pragma("unroll") for (int m = 0; m < 4; ++m) _Pragma("unroll") for (int k = 0; k < 2; ++k) dst[m][k] = *(const LAS bf16x8*)(lds + PG8_SA(b, h) + aoff + m * 2048 + k * 1024); } while (0)
#define PG8_LDB(dst, b, h) do { _Pragma("unroll") for (int n = 0; n < 2; ++n) _Pragma("unroll") for (int k = 0; k < 2; ++k) dst[n][k] = *(const LAS bf16x8*)(lds + PG8_SB(b, h) + boff + n * 2048 + k * 1024); } while (0)
#define PG8_CAT(x) __builtin_bit_cast(i32x8, __builtin_shufflevector((x)[0], (x)[1], 0, 1, 2, 3, 4, 5, 6, 7, 8, 9, 10, 11, 12, 13, 14, 15))
#define PG8_MMA(ai, bj, At, Bt) do { __builtin_amdgcn_s_setprio(1); \
        if constexpr (FP8) { const i32x8 a0_ = PG8_CAT(At[0]), a1_ = PG8_CAT(At[1]), a2_ = PG8_CAT(At[2]), a3_ = PG8_CAT(At[3]), b0_ = PG8_CAT(Bt[0]), b1_ = PG8_CAT(Bt[1]); \
            asm volatile("s_nop 1\n\tv_mfma_f32_16x16x128_f8f6f4 %0, %8, %10, %0\n\tv_mfma_f32_16x16x128_f8f6f4 %1, %9, %10, %1\n\tv_mfma_f32_16x16x128_f8f6f4 %2, %8, %11, %2\n\tv_mfma_f32_16x16x128_f8f6f4 %3, %9, %11, %3\n\t" \
                         "v_mfma_f32_16x16x128_f8f6f4 %4, %8, %12, %4\n\tv_mfma_f32_16x16x128_f8f6f4 %5, %9, %12, %5\n\tv_mfma_f32_16x16x128_f8f6f4 %6, %8, %13, %6\n\tv_mfma_f32_16x16x128_f8f6f4 %7, %9, %13, %7" \
                : "+v"(acc[ai][bj][0][0]), "+v"(acc[ai][bj][0][1]), "+v"(acc[ai][bj][1][0]), "+v"(acc[ai][bj][1][1]), "+v"(acc[ai][bj][2][0]), "+v"(acc[ai][bj][2][1]), "+v"(acc[ai][bj][3][0]), "+v"(acc[ai][bj][3][1]) \
                : "v"(b0_), "v"(b1_), "v"(a0_), "v"(a1_), "v"(a2_), "v"(a3_)); } \
        else { _Pragma("unroll") for (int m = 0; m < 4; ++m) _Pragma("unroll") for (int n = 0; n < 2; ++n) _Pragma("unroll") for (int k = 0; k < 2; ++k) \
            acc[ai][bj][m][n] = __builtin_amdgcn_mfma_f32_16x16x32_bf16(Bt[n][k], At[m][k], acc[ai][bj][m][n], 0, 0, 0); } \
        __builtin_amdgcn_s_setprio(0); } while (0)
#define PG8_WAIT_V(n) asm volatile("s_waitcnt vmcnt(" #n ")" ::: "memory")
#define PG8_WAIT_L(n) asm volatile("s_waitcnt lgkmcnt(" #n ")" ::: "memory")
#define PG8_BAR __builtin_amdgcn_s_barrier()
#define PG8_SCHED __builtin_amdgcn_sched_barrier(0)
    Unit cur, nxt; int ui = 0;
    if (!S.next(0, cur)) return;
    f32x4 acc[2][2][4][2];
#pragma unroll
    for (int a = 0; a < 2; ++a)
#pragma unroll
        for (int b = 0; b < 2; ++b)
#pragma unroll
            for (int m = 0; m < 4; ++m)
#pragma unroll
                for (int n = 0; n < 2; ++n) acc[a][b][m][n] = (f32x4){0.f, 0.f, 0.f, 0.f};
    bf16x8 At[4][2], B0[2][2], B1[2][2];
    unsigned vAc[4], vAn[4];
    S.a_off(cur, R, C, vAc);
    const char* cA = cur.A; const char* cB = cur.B;
    PG8_STAGE_B(PG8_SB(0, 0), cB); PG8_STAGE_B(PG8_SB(0, 1), cB + hstepB); PG8_STAGE_A(PG8_SA(0, 0), cA, vAc, 0); PG8_STAGE_A(PG8_SA(0, 1), cA, vAc, 1);
    if (wr == 1) PG8_BAR;
    PG8_WAIT_V(2); PG8_BAR;
    PG8_STAGE_B(PG8_SB(1, 0), cB + kstep); PG8_STAGE_A(PG8_SA(1, 0), cA + kstep, vAc, 0); PG8_STAGE_B(PG8_SB(1, 1), cB + hstepB + kstep);
    PG8_WAIT_V(6); PG8_BAR;
    for (;;) {
        const bool has_next = S.next(ui + 1, nxt);
        const char* nA = has_next ? nxt.A : cA; const char* nB = has_next ? nxt.B : cB;
#pragma unroll
        for (int q = 0; q < 4; ++q) vAn[q] = vAc[q];
        cur.par = ui & 1;
        if constexpr (has_pre<Epi>::value) { if (wid == 0) E.pre(cur, lds + PRE_OFF + 1024 * (ui & 1)); }
        for (int t = 0; t < nt; t += 2) {
            const bool last = (t == nt - 2);
            if (Sched::A_PER_UNIT) { if (has_next && t == (nt >= 4 ? nt - 4 : nt - 2)) S.a_off(nxt, R, C, vAn); }
            const char* a1 = cA + (size_t)(t + 1) * kstep;
            const char* a2 = last ? nA : cA + (size_t)(t + 2) * kstep; const char* b2 = last ? nB : cB + (size_t)(t + 2) * kstep;
            const char* a3 = a2 + kstep; const char* b3 = b2 + kstep;
            unsigned v2[4];
#pragma unroll
            for (int q = 0; q < 4; ++q) v2[q] = (Sched::A_PER_UNIT && last) ? vAn[q] : vAc[q];
            PG8_LDB(B0, 0, 0); PG8_LDB(B1, 0, 1); PG8_SCHED; PG8_LDA(At, 0, 0); PG8_STAGE_A(PG8_SA(1, 1), a1, vAc, 1);
            PG8_WAIT_V(8); PG8_WAIT_L(0); PG8_BAR; PG8_MMA(0, 0, At, B0); PG8_MMA(0, 1, At, B1); PG8_BAR; PG8_SCHED;
            PG8_LDA(At, 0, 1); PG8_STAGE_B(PG8_SB(0, 0), b2); PG8_STAGE_B(PG8_SB(0, 1), b2 + hstepB); PG8_STAGE_A(PG8_SA(0, 0), a2, v2, 0);
            PG8_WAIT_V(8); PG8_WAIT_L(0); PG8_BAR; PG8_MMA(1, 0, At, B0); PG8_MMA(1, 1, At, B1); PG8_BAR; PG8_SCHED;
            PG8_LDB(B0, 1, 0); PG8_LDB(B1, 1, 1); PG8_SCHED; PG8_LDA(At, 1, 0); PG8_STAGE_A(PG8_SA(0, 1), a2, v2, 1);
            PG8_WAIT_V(8); PG8_WAIT_L(0); PG8_BAR; PG8_MMA(0, 0, At, B0); PG8_MMA(0, 1, At, B1); PG8_BAR; PG8_SCHED;
            PG8_LDA(At, 1, 1); PG8_STAGE_B(PG8_SB(1, 0), b3); PG8_STAGE_B(PG8_SB(1, 1), b3 + hstepB); PG8_STAGE_A(PG8_SA(1, 0), a3, v2, 0);
            PG8_WAIT_V(8); PG8_WAIT_L(0); PG8_BAR; PG8_MMA(1, 0, At, B0); PG8_MMA(1, 1, At, B1); PG8_BAR; PG8_SCHED;
        }
        if (wr == 0) PG8_BAR;
        if constexpr (FP8) asm volatile("s_nop 15\n\ts_nop 15" ::: "memory");
        E(acc, cur, wr, wc, fr, fq);
        if (!has_next) break;
        if (!cur.keep)
#pragma unroll
        for (int a = 0; a < 2; ++a)
#pragma unroll
            for (int b = 0; b < 2; ++b)
#pragma unroll
                for (int m = 0; m < 4; ++m)
#pragma unroll
                    for (int n = 0; n < 2; ++n) acc[a][b][m][n] = (f32x4){0.f, 0.f, 0.f, 0.f};
        cur = nxt; cA = nA; cB = nB; ++ui;
#pragma unroll
        for (int q = 0; q < 4; ++q) vAc[q] = vAn[q];
        if (wr == 1) PG8_BAR;
    }
    PG8_WAIT_V(0);
    PG8_BAR;
#undef PG8_SA
#undef PG8_SB
#undef PG8_STAGE_A
#undef PG8_STAGE_B
#undef PG8_LDA
#undef PG8_LDB
#undef PG8_MMA
#undef PG8_CAT
#undef PG8_WAIT_V
#undef PG8_WAIT_L
#undef PG8_BAR
#undef PG8_SCHED
}
}
struct Params { const float* in[25]; float* out; unsigned char* ws; double rope_r; };
enum { I_X = 0, I_NORM_MIX, I_W_IN, I_CPOS_K, I_CPOS_V, I_WCK1, I_WCK2, I_WCV1, I_WCV2, I_WGA, I_BGA, I_GLA_NORM, I_WPN, I_WPG, I_WMG, I_BMG, I_WOUT, I_NORM_MOE, I_WR, I_BR, I_WGU, I_BGU, I_WDN, I_BDN, I_NORM_FINAL };

struct Frame { LAS unsigned char* lds; int tid, lane, wave, G, bid; unsigned* ctl; };

constexpr int CVT_J0 = 0, CVT_J2 = CVT_J0 + 92 * 16, CVT_J3 = CVT_J2 + 256, CVT_J4 = CVT_J3 + 256, CVT_J5 = CVT_J4 + 512, CVT_J6 = CVT_J5 + 128, CVT_END = CVT_J6 + 128;
constexpr int CVT8_GU = 32 * 512, CVT8_DN = CVT8_GU + 32 * 256;
constexpr int CVT8_W1I = CVT8_DN + 0, CVT8_END = CVT8_W1I + 64 * 8;
DI int map_in1(int j) {
    const int t = j >> 8, p = j & 255;
    if (t < 10) { const int bj = p >> 7, x = p & 127, hd = x >> 6, d = (x & 63) + 64 * bj; return (t < 4) ? (2 * t + hd) * 128 + d : OFF_KV + (t - 4) * 256 + hd * 128 + d; }
    if (t < 22) return OFF_QG + (t - 10) * 256 + p;
    return p < 24 ? OFF_GN + p : (p < 40 ? OFF_AG + (p - 24) : -1);
}
DI int tileA_old(int ta) { return ta; }
DI int tileB_old(int tb) { return 23 + tb; }
DI int map_gu(int j) { const int pn = j >> 8, p = j & 255, bj = p >> 7, x = p & 127; return bj * FF + pn * 128 + x; }
struct CvtDesc { const float* src; bf16_t* dst; int ld, K, j0, k0, col, dK; };
DI void cvt_decode(const Params& P, int tid, int g, CvtDesc& d) {
    const float* src; bf16_t* dst; int ld, K, loc, kind = 0, nrt = 32, dK = 0;
    unsigned char* ws = P.ws;
    if (g < CVT_J2)      { nrt = 92; loc = g - CVT_J0; src = P.in[I_W_IN]; ld = IN_W; K = 2048; dst = (bf16_t*)(ws + WS_WT1); kind = 1; }
    else if (g < CVT_J3) { loc = g - CVT_J2; src = P.in[I_WPN]; ld = 2048; K = 1024; dst = (bf16_t*)(ws + WS_WPN); dK = 2048; }
    else if (g < CVT_J4) { loc = g - CVT_J3; src = P.in[I_WPG]; ld = 2048; K = 1024; dst = (bf16_t*)(ws + WS_WPN) + 1024; dK = 2048; }
    else if (g < CVT_J5) { loc = g - CVT_J4; src = P.in[I_WOUT]; ld = 2048; K = 2048; dst = (bf16_t*)(ws + WS_WOUT); }
    else if (g < CVT_J6) { nrt = 4; loc = g - CVT_J5; src = P.in[I_WCK1]; ld = 256; K = 4096; dst = (bf16_t*)(ws + WS_WCK1); }
    else                 { nrt = 4; loc = g - CVT_J6; src = P.in[I_WCV1]; ld = 256; K = 4096; dst = (bf16_t*)(ws + WS_WCV1); }
    d.dK = dK ? dK : K;
    d.src = src; d.dst = dst; d.ld = ld; d.K = K; d.j0 = (loc % nrt) * 64; d.k0 = (loc / nrt) * 128;
    const int jj = d.j0 + 4 * (tid & 15);
    d.col = kind == 1 ? map_in1(tileA_old(jj >> 8) * 256 + (jj & 255)) : (kind == 2 ? map_gu(jj) : jj);
}
DI void cvt_load(const CvtDesc& d, int tid, f32x4 (&v)[4]) {
    const int kp = tid >> 4;
#pragma unroll
    for (int it = 0; it < 2; ++it) {
        const int k = d.k0 + 2 * kp + 64 * it;
        if (d.col >= 0) { v[2 * it] = __builtin_nontemporal_load((const f32x4*)(d.src + (size_t)k * d.ld + d.col)); v[2 * it + 1] = __builtin_nontemporal_load((const f32x4*)(d.src + (size_t)(k + 1) * d.ld + d.col)); }
        else { v[2 * it] = (f32x4){0.f, 0.f, 0.f, 0.f}; v[2 * it + 1] = v[2 * it]; }
    }
}
DI void cvt_finish(const CvtDesc& d, LAS unsigned* T, int tid, const f32x4 (&v)[4]) {
    const int jq = tid & 15, kp = tid >> 4;
#pragma unroll
    for (int it = 0; it < 2; ++it)
#pragma unroll
        for (int c = 0; c < 4; ++c) T[(4 * jq + c) * 65 + kp + 32 * it] = cvt_pk_bf16(v[2 * it][c], v[2 * it + 1][c]);
    LDS_BARRIER();
#pragma unroll
    for (int i = 0; i < 2; ++i) {
        const int p = tid + 512 * i, j = p >> 4, c = p & 15;
        u32x4 o; o.x = T[j * 65 + 4 * c + 0]; o.y = T[j * 65 + 4 * c + 1]; o.z = T[j * 65 + 4 * c + 2]; o.w = T[j * 65 + 4 * c + 3];
        *(u32x4*)(d.dst + (size_t)(d.j0 + j) * d.dK + d.k0 + 8 * c) = o;
    }
}
DI void cvt_all(const Params& P, const Frame& F) {
    const int tid = F.tid, G = F.G;
    CvtDesc d0, d1, d2; f32x4 va[4], vb[4], vc[4];
    int g = F.bid;
    if (g >= CVT_END) return;
    cvt_decode(P, tid, g, d0); cvt_load(d0, tid, va);
    if (g + G < CVT_END) { cvt_decode(P, tid, g + G, d1); cvt_load(d1, tid, vb); }
    int par = 0;
    for (; g < CVT_END; g += G) {
        if (g + 2 * G < CVT_END) { cvt_decode(P, tid, g + 2 * G, d2); cvt_load(d2, tid, vc); }
        cvt_finish(d0, (LAS unsigned*)(F.lds + par * 16640), tid, va);
        par ^= 1;
        d0 = d1; d1 = d2;
#pragma unroll
        for (int i = 0; i < 4; ++i) { va[i] = vb[i]; vb[i] = vc[i]; }
    }
    __syncthreads();
}

struct Cvt8Desc { const float* src; unsigned char* dst; int ld, Kb, j0, k0, col; };
DI void cvt8_decode(const Params& P, int tid, int g, Cvt8Desc& d) {
    unsigned char* ws = P.ws; int loc, nrt, kind;
    d.Kb = 2048;
    if (g < CVT8_GU) { const int e = g >> 9; loc = g & 511; nrt = 64; kind = 2; d.src = P.in[I_WGU] + (size_t)e * 2048 * 4096; d.ld = 4096; d.dst = ws + WS_WGU + (size_t)e * 4096 * 2048; }
    else if (g < CVT8_DN) { const int gg = g - CVT8_GU, e = gg >> 8; loc = gg & 255; nrt = 32; kind = 0; d.src = P.in[I_WDN] + (size_t)e * 2048 * 2048; d.ld = 2048; d.dst = ws + WS_WDN + (size_t)e * 2048 * 2048; }
    else if (g < CVT8_W1I) { loc = g - CVT8_DN; nrt = 28; kind = 3; d.src = P.in[I_W_IN]; d.ld = IN_W; d.dst = ws + WS_WT1B; }
    else { loc = g - CVT8_W1I; nrt = 64; kind = 0; d.src = P.in[I_WMG]; d.ld = 4096; d.dst = ws + WS_WT1B; }
    d.j0 = (loc % nrt) * 64; d.k0 = (loc / nrt) * 256;
    const int jj = d.j0 + 4 * (tid & 15);
    d.col = kind == 2 ? map_gu(jj) : (kind == 3 ? map_in1(tileB_old(jj >> 8) * 256 + (jj & 255)) : jj);
}
DI void cvt8_load(const Cvt8Desc& d, int tid, f32x4 (&v)[8]) {
    const float* p = d.src + (size_t)(d.k0 + 8 * (tid >> 4)) * d.ld + d.col;
#pragma unroll
    for (int r = 0; r < 8; ++r) v[r] = __builtin_nontemporal_load((const f32x4*)(p + (size_t)r * d.ld));
}
DI void cvt8_finish(const Cvt8Desc& d, LAS unsigned* T, int tid, const f32x4 (&v)[8]) {
    const int jq = tid & 15, kg = tid >> 4;
#pragma unroll
    for (int c = 0; c < 4; ++c) {
        T[(4 * jq + c) * 65 + 2 * kg] = pk4_fp8(v[0][c] * W8_SCALE, v[1][c] * W8_SCALE, v[2][c] * W8_SCALE, v[3][c] * W8_SCALE);
        T[(4 * jq + c) * 65 + 2 * kg + 1] = pk4_fp8(v[4][c] * W8_SCALE, v[5][c] * W8_SCALE, v[6][c] * W8_SCALE, v[7][c] * W8_SCALE);
    }
    LDS_BARRIER();
#pragma unroll
    for (int i = 0; i < 2; ++i) {
        const int p = tid + 512 * i, j = p >> 4, c = p & 15;
        u32x4 o; o.x = T[j * 65 + 4 * c + 0]; o.y = T[j * 65 + 4 * c + 1]; o.z = T[j * 65 + 4 * c + 2]; o.w = T[j * 65 + 4 * c + 3];
        *(u32x4*)(d.dst + (size_t)(d.j0 + j) * d.Kb + d.k0 + 16 * c) = o;
    }
}
DI void cvt8_issue(const Params& P, int tid, int g, int gend, f32x4 (&v)[8]) { if (g < gend) { Cvt8Desc d; cvt8_decode(P, tid, g, d); cvt8_load(d, tid, v); } }
DI void cvt8_done(const Params& P, const Frame& F, int g, int gend, int& par, const f32x4 (&v)[8]) {
    if (g < gend) { Cvt8Desc d; cvt8_decode(P, F.tid, g, d); cvt8_finish(d, (LAS unsigned*)(F.lds + par * 16640), F.tid, v); par ^= 1; } }
DI void cvt8_range(const Params& P, const Frame& F, int gbeg, int gend) {
    const int tid = F.tid, G = F.G;
    f32x4 va[8], vb[8], vc[8];
    int g = gbeg + F.bid, par = 0;
    cvt8_issue(P, tid, g, gend, va); cvt8_issue(P, tid, g + G, gend, vb);
    for (; g < gend; g += 3 * G) {
        cvt8_issue(P, tid, g + 2 * G, gend, vc); cvt8_done(P, F, g, gend, par, va);
        cvt8_issue(P, tid, g + 3 * G, gend, va); cvt8_done(P, F, g + G, gend, par, vb);
        cvt8_issue(P, tid, g + 4 * G, gend, vb); cvt8_done(P, F, g + 2 * G, gend, par, vc);
    }
    __syncthreads();
}

DI void rms_row_bf16(const float* x, const float* gain, bf16_t* out, unsigned char* out8, int lane) {
    f32x4 v[8]; float ss = 0.f;
#pragma unroll
    for (int i = 0; i < 8; ++i) { v[i] = *(const f32x4*)(x + (i * 64 + lane) * 4); ss += v[i][0] * v[i][0] + v[i][1] * v[i][1] + v[i][2] * v[i][2] + v[i][3] * v[i][3]; }
    ss = wave_sum(ss);
    const float rs = __builtin_amdgcn_rsqf(ss * (1.0f / 2048.0f) + NORM_EPS);
#pragma unroll
    for (int i = 0; i < 8; ++i) { const f32x4 g = *(const f32x4*)(gain + (i * 64 + lane) * 4);
        u32x2 w; w.x = cvt_pk_bf16(v[i][0] * rs * g[0], v[i][1] * rs * g[1]); w.y = cvt_pk_bf16(v[i][2] * rs * g[2], v[i][3] * rs * g[3]);
        *(u32x2*)(out + (i * 64 + lane) * 4) = w;
        *(unsigned*)(out8 + (i * 64 + lane) * 4) = pk4_fp8(v[i][0] * rs * g[0], v[i][1] * rs * g[1], v[i][2] * rs * g[2], v[i][3] * rs * g[3]); }
}

DI void rms_rows2(const float* x0, const float* x1, bool two, const float* gain, bf16_t* o0, bf16_t* o1, unsigned char* p0, unsigned char* p1, int lane) {
    f32x4 v[2][8]; float ss0 = 0.f, ss1 = 0.f;
#pragma unroll
    for (int i = 0; i < 8; ++i) { v[0][i] = *(const f32x4*)(x0 + (i * 64 + lane) * 4); v[1][i] = *(const f32x4*)(x1 + (i * 64 + lane) * 4); }
#pragma unroll
    for (int i = 0; i < 8; ++i) { ss0 += v[0][i][0] * v[0][i][0] + v[0][i][1] * v[0][i][1] + v[0][i][2] * v[0][i][2] + v[0][i][3] * v[0][i][3];
                                  ss1 += v[1][i][0] * v[1][i][0] + v[1][i][1] * v[1][i][1] + v[1][i][2] * v[1][i][2] + v[1][i][3] * v[1][i][3]; }
    ss0 = wave_sum(ss0); ss1 = wave_sum(ss1);
    const float rs0 = __builtin_amdgcn_rsqf(ss0 * (1.0f / 2048.0f) + NORM_EPS), rs1 = __builtin_amdgcn_rsqf(ss1 * (1.0f / 2048.0f) + NORM_EPS);
#pragma unroll
    for (int i = 0; i < 8; ++i) { const f32x4 g = *(const f32x4*)(gain + (i * 64 + lane) * 4);
        { const f32x4 y = v[0][i] * rs0 * g; u32x2 w; w.x = cvt_pk_bf16(y[0], y[1]); w.y = cvt_pk_bf16(y[2], y[3]); *(u32x2*)(o0 + (i * 64 + lane) * 4) = w; *(unsigned*)(p0 + (i * 64 + lane) * 4) = pk4_fp8(y[0], y[1], y[2], y[3]); }
        if (two) { const f32x4 y = v[1][i] * rs1 * g; u32x2 w; w.x = cvt_pk_bf16(y[0], y[1]); w.y = cvt_pk_bf16(y[2], y[3]); *(u32x2*)(o1 + (i * 64 + lane) * 4) = w; *(unsigned*)(p1 + (i * 64 + lane) * 4) = pk4_fp8(y[0], y[1], y[2], y[3]); } }
}

DI void p0_prologue(const Params& P, const Frame& F) {
    unsigned char* ws = P.ws;
    { const int stride = F.G * 8;
      for (int row = F.bid * 8 + F.wave; row < NTOK; row += 2 * stride) { const bool two = row + stride < NTOK; const int r1 = two ? row + stride : row;
          rms_rows2(P.in[I_X] + (size_t)row * DM, P.in[I_X] + (size_t)r1 * DM, two, P.in[I_NORM_MIX], (bf16_t*)(ws + WS_HN) + (size_t)row * DM, (bf16_t*)(ws + WS_HN) + (size_t)r1 * DM,
                    ws + WS_HN8 + (size_t)row * DM, ws + WS_HN8 + (size_t)r1 * DM, F.lane); } }
    for (int idx = F.bid * 512 + F.tid; idx < SEQ * 64; idx += F.G * 512) {
        const int s = idx >> 6, i = idx & 63;
        double f = 1.0, r = P.rope_r; int e = i;
        while (e) { if (e & 1) f *= r; r *= r; e >>= 1; }
        const double a = (double)s * (double)(float)f * 0.15915494309189535;
        const float fr = (float)(a - __builtin_rint(a));
        f32x2 cs; cs.x = __builtin_amdgcn_cosf(fr); cs.y = __builtin_amdgcn_sinf(fr);
        *(f32x2*)(ws + WS_TAB + (size_t)idx * 8) = cs;
    }
    for (int idx = F.bid * 512 + F.tid; idx < NEXP * DM; idx += F.G * 512) {
        const int e = idx >> 11, k = idx & 2047;
        const float w = P.in[I_WR][k * NEXP + e] * P.in[I_NORM_MOE][k];
        const bf16_t hi = f2bf(w); const bf16_t lo = f2bf(w - bf2f(hi));
        ((bf16_t*)(ws + WS_WRT))[idx] = hi; ((bf16_t*)(ws + WS_WRT))[NEXP * DM + idx] = lo;
    }
    if (F.bid >= F.G - 32) {
        const int chunk = F.bid - (F.G - 32), kv = F.tid >> 8, c = F.tid & 255;
        const float* pos = P.in[kv ? I_CPOS_V : I_CPOS_K] + chunk * 128; const float* w1 = P.in[kv ? I_WCV1 : I_WCK1] + (size_t)chunk * 128 * 256 + c;
        float a0 = 0.f, a1 = 0.f, a2 = 0.f, a3 = 0.f;
#pragma unroll 8
        for (int k = 0; k < 128; k += 4) { a0 += pos[k] * w1[(size_t)k * 256]; a1 += pos[k + 1] * w1[(size_t)(k + 1) * 256]; a2 += pos[k + 2] * w1[(size_t)(k + 2) * 256]; a3 += pos[k + 3] * w1[(size_t)(k + 3) * 256]; }
        ((float*)(ws + WS_CBIAS))[chunk * 512 + F.tid] = (a0 + a1) + (a2 + a3);
    }
    cvt_all(P, F);
    cvt8_range(P, F, CVT8_DN, CVT8_END);
#ifndef SPLIT_CONV
    cvt8_range(P, F, 0, CVT8_DN);
#endif
}
using pg8::Unit;
typedef f32x4 Acc[2][2][4][2];
DI void st8(bf16_t* p, const f32x4 a, const f32x4 b) { u32x4 w; w.x = cvt_pk_bf16(a[0], a[1]); w.y = cvt_pk_bf16(a[2], a[3]); w.z = cvt_pk_bf16(b[0], b[1]); w.w = cvt_pk_bf16(b[2], b[3]); *(u32x4*)p = w; }

struct SchedStd {
    static constexpr bool A_PER_UNIT = false;
    const char* A; const char* B; unsigned lda, ldb; int nM, nN, G, c;
    DI bool next(int i, Unit& u) const { int pm, pn; if (!pg8::static_tile(i, G, c, nM, nN, pm, pn)) return false;
        u.A = A + (size_t)pm * 256 * lda; u.B = B + (size_t)pn * 256 * ldb; u.pm = pm; u.pn = pn; u.aux = 0; u.rows = 256; u.keep = 0; return true; }
    DI void a_off(const Unit&, const int (&R)[2], const int (&C)[2], unsigned (&v)[4]) const {
#pragma unroll
        for (int h = 0; h < 2; ++h)
#pragma unroll
            for (int i = 0; i < 2; ++i) v[h * 2 + i] = (unsigned)(h * 128 + R[i]) * lda + (unsigned)C[i] * 2u; }
};

struct SchedStdB {
    static constexpr bool A_PER_UNIT = false;
    const char* A; const char* B; unsigned lda, ldb; int nM, nN, G, c;
    DI bool next(int i, Unit& u) const { int pm, pn; long L;
        if (i < 5) L = (long)i * 160 + c; else if (i == 5) { if (c < 32) return false; L = 800 + (c - 32); } else if (i == 6) { if (c < 64) return false; L = 928 + (c - 64); } else return false;
        if (!pg8::static_tile_lin(L, nM, nN, pm, pn)) return false;
        u.A = A + (size_t)pm * 256 * lda; u.B = B + (size_t)pn * 256 * ldb; u.pm = pm; u.pn = pn; u.aux = 0; u.rows = 256; u.keep = 0; return true; }
    DI void a_off(const Unit&, const int (&R)[2], const int (&C)[2], unsigned (&v)[4]) const {
#pragma unroll
        for (int h = 0; h < 2; ++h)
#pragma unroll
            for (int i = 0; i < 2; ++i) v[h * 2 + i] = (unsigned)(h * 128 + R[i]) * lda + (unsigned)C[i] * 2u; }
};

template <bool FP8> struct Epi1 {
    unsigned char* ws; const float* bmg;
    static constexpr bool PRE = FP8; LAS unsigned char* lds;
    DI void pre(const Unit& u, LAS unsigned char* slot) const {
        const int l = threadIdx.x & 63; __builtin_amdgcn_global_load_lds((const unsigned*)(bmg + (tileB_old(u.pn) - 23) * 256 + l * 4), (LAS unsigned*)slot, 16, 0, 0); }
    DI void operator()(const Acc& acc_, const Unit& u, int wr, int wc, int fr, int fq) const {
        const Acc& acc = acc_;
        const int t = FP8 ? tileB_old(u.pn) : tileA_old(u.pn), row0 = u.pm * 256 + wr * 64 + fr, x0 = wc * 32 + fq * 8;
        if (!FP8 && t < 10) {
            const int hd = wc >> 1, dlo = (wc & 1) * 32 + fq * 8;
            const bool isq = t < 4, rope = t == 6 || t == 8;
            const f32x2* tab = (const f32x2*)(ws + WS_TAB);
#pragma unroll
            for (int ai = 0; ai < 2; ++ai)
#pragma unroll
                for (int m = 0; m < 4; ++m) {
                    const int row = row0 + ai * 128 + m * 16, s = row & (SEQ - 1), b = row >> 11;
                    const f32x4 a0 = acc[ai][0][m][0], a1 = acc[ai][0][m][1], b0 = acc[ai][1][m][0], b1 = acc[ai][1][m][1];
                    f32x4 l0 = a0, l1 = a1, h0 = b0, h1 = b1;
                    if (rope) {
                        const f32x4* tp = (const f32x4*)(tab + s * 64 + dlo);
                        const f32x4 c01 = tp[0], c23 = tp[1], c45 = tp[2], c67 = tp[3];
                        l0[0] = a0[0] * c01[0] - b0[0] * c01[1]; h0[0] = b0[0] * c01[0] + a0[0] * c01[1];
                        l0[1] = a0[1] * c01[2] - b0[1] * c01[3]; h0[1] = b0[1] * c01[2] + a0[1] * c01[3];
                        l0[2] = a0[2] * c23[0] - b0[2] * c23[1]; h0[2] = b0[2] * c23[0] + a0[2] * c23[1];
                        l0[3] = a0[3] * c23[2] - b0[3] * c23[3]; h0[3] = b0[3] * c23[2] + a0[3] * c23[3];
                        l1[0] = a1[0] * c45[0] - b1[0] * c45[1]; h1[0] = b1[0] * c45[0] + a1[0] * c45[1];
                        l1[1] = a1[1] * c45[2] - b1[1] * c45[3]; h1[1] = b1[1] * c45[2] + a1[1] * c45[3];
                        l1[2] = a1[2] * c67[0] - b1[2] * c67[1]; h1[2] = b1[2] * c67[0] + a1[2] * c67[1];
                        l1[3] = a1[3] * c67[2] - b1[3] * c67[3]; h1[3] = b1[3] * c67[2] + a1[3] * c67[3];
                    }
                    if (isq) {
                        const size_t o = (size_t)row * 1024 + (2 * t + hd) * 128 + dlo;
                        bf16_t* qraw = (bf16_t*)(ws + WS_QRAW) + o;
                        st8(qraw, a0, a1); st8(qraw + 64, b0, b1);
                    } else {
                        bf16_t* kv = (bf16_t*)(ws + WS_KV + (size_t)(t - 4) * KV_STRIDE) + ((size_t)((b * 2 + hd) * SEQ + s)) * 128 + dlo;
                        st8(kv, l0, l1); st8(kv + 64, h0, h1);
                    }
                }
        } else if (!FP8 && t < 22) {
            bf16_t* base; int ldc, c0;
            if (t < 12) { base = (bf16_t*)(ws + WS_QG); ldc = 512; c0 = (t - 10) * 256; }
            else if (t < 14) { base = (bf16_t*)(ws + WS_KG); ldc = 512; c0 = (t - 12) * 256; }
            else if (t < 18) { base = (bf16_t*)(ws + WS_VG); ldc = 1024; c0 = (t - 14) * 256; }
            else { base = (bf16_t*)(ws + WS_RG); ldc = 1024; c0 = (t - 18) * 256; }
#pragma unroll
            for (int ai = 0; ai < 2; ++ai)
#pragma unroll
                for (int m = 0; m < 4; ++m) { bf16_t* rp = base + (size_t)(row0 + ai * 128 + m * 16) * ldc + c0 + x0;
#pragma unroll
                    for (int bj = 0; bj < 2; ++bj) st8(rp + bj * 128, acc[ai][bj][m][0], acc[ai][bj][m][1]); }
        } else if (!FP8 && t == 22) {
            if (wc < 2) {
#pragma unroll
                for (int ai = 0; ai < 2; ++ai)
#pragma unroll
                    for (int m = 0; m < 4; ++m) { float* rp = (float*)(ws + WS_SMALL) + (size_t)(row0 + ai * 128 + m * 16) * 64 + x0;
                        *(f32x4*)rp = acc[ai][0][m][0]; *(f32x4*)(rp + 4) = acc[ai][0][m][1]; }
            }
        } else {
            const int c0 = (t - 23) * 256 + x0;
            f32x4 bv[2][2];
#pragma unroll
            for (int bj = 0; bj < 2; ++bj)
#pragma unroll
                for (int n = 0; n < 2; ++n) bv[bj][n] = (FP8 ? *(const LAS f32x4*)((const LAS float*)(lds + pg8::PRE_OFF + 1024 * u.par) + x0 + bj * 128 + 4 * n) : *(const f32x4*)(bmg + c0 + bj * 128 + 4 * n)) * -1.4426950408889634f;
            float ws_ = (FP8 ? W8_INV : 1.0f) * -1.4426950408889634f; asm volatile("" : "+v"(ws_));
            float k255 = 1.0f / 255.0f; asm volatile("" : "+v"(k255));
#pragma unroll
            for (int ai = 0; ai < 2; ++ai)
#pragma unroll
                for (int m = 0; m < 4; ++m) { unsigned char* rp = ws + WS_MG + (size_t)(row0 + ai * 128 + m * 16) * 4096 + c0;
#pragma unroll
                    for (int bj = 0; bj < 2; ++bj) { u32x2 w;
#pragma unroll
                        for (int n = 0; n < 2; ++n) {
                            const f32x4 tq = acc[ai][bj][m][n] * ws_ + bv[bj][n]; unsigned q = 0u;
#pragma unroll
                            for (int i = 0; i < 4; ++i) { const float e = __builtin_amdgcn_exp2f(tq[i]); q = __builtin_amdgcn_cvt_pk_u8_f32(__builtin_amdgcn_rcpf(__builtin_fmaf(e, k255, k255)), i, q); }
                            if (n == 0) w.x = q; else w.y = q; }
                        *(u32x2*)(rp + bj * 128) = w; } }
        }
    }
};
struct SchedProj {
    static constexpr bool A_PER_UNIT = false;
    const char* A; const char* B; int G, c;
    DI bool next(int i, Unit& u) const { int pm, pn; if (!pg8::static_tile(i >> 1, G, c, 64, 8, pm, pn)) return false; const int half = i & 1;
        u.A = A + (size_t)pm * 256 * 4096 + half * 2048; u.B = B + (size_t)pn * 256 * 4096 + half * 2048; u.pm = pm; u.pn = pn; u.aux = half; u.rows = 256; u.keep = half == 0; return true; }
    DI void a_off(const Unit&, const int (&R)[2], const int (&C)[2], unsigned (&v)[4]) const {
#pragma unroll
        for (int h = 0; h < 2; ++h)
#pragma unroll
            for (int i = 0; i < 2; ++i) v[h * 2 + i] = (unsigned)(h * 128 + R[i]) * 4096u + (unsigned)C[i] * 2u; }
};
struct EpiProjF {
    unsigned char* ws;
    DI void operator()(Acc& acc, const Unit& u, int wr, int wc, int fr, int fq) const {
        const int row0 = u.pm * 256 + wr * 64 + fr, c0 = u.pn * 256 + wc * 32 + fq * 8;
        const unsigned char* mg = ws + WS_MG;
        if (u.aux == 0) {
#pragma unroll
            for (int ai = 0; ai < 2; ++ai)
#pragma unroll
                for (int m = 0; m < 4; ++m) { const unsigned char* gp = mg + (size_t)(row0 + ai * 128 + m * 16) * 4096 + c0;
#pragma unroll
                    for (int bj = 0; bj < 2; ++bj) { const u32x2 g1 = *(const u32x2*)(gp + bj * 128), g2 = *(const u32x2*)(gp + 2048 + bj * 128);
                        f32x4& v0 = acc[ai][bj][m][0]; f32x4& v1 = acc[ai][bj][m][1];
#pragma unroll
                        for (int i = 0; i < 4; ++i) {
                            v0[i] *= (float)((g1.x >> (8 * i)) & 255u) * __builtin_amdgcn_rcpf(fmaxf((float)((g2.x >> (8 * i)) & 255u), 0.5f));
                            v1[i] *= (float)((g1.y >> (8 * i)) & 255u) * __builtin_amdgcn_rcpf(fmaxf((float)((g2.y >> (8 * i)) & 255u), 0.5f)); } } }
        } else {
#pragma unroll
            for (int ai = 0; ai < 2; ++ai)
#pragma unroll
                for (int m = 0; m < 4; ++m) { const size_t row = (size_t)(row0 + ai * 128 + m * 16);
                    const unsigned char* gp = mg + row * 4096 + 2048 + c0; bf16_t* op = (bf16_t*)(ws + WS_MIXED) + row * 2048 + c0;
#pragma unroll
                    for (int bj = 0; bj < 2; ++bj) { const u32x2 g = *(const u32x2*)(gp + bj * 128);
                        f32x4 v0 = acc[ai][bj][m][0], v1 = acc[ai][bj][m][1];
#pragma unroll
                        for (int i = 0; i < 4; ++i) { v0[i] *= fmaxf((float)((g.x >> (8 * i)) & 255u), 0.5f) * (1.0f / 255.0f); v1[i] *= fmaxf((float)((g.y >> (8 * i)) & 255u), 0.5f) * (1.0f / 255.0f); }
                        st8(op + bj * 128, v0, v1); } }
        }
    }
};
struct EpiOut {
    const float* x; bf16_t* x2; float* ssqp;
    DI void operator()(const Acc& acc, const Unit& u, int wr, int wc, int fr, int fq) const {
        const int row0 = u.pm * 256 + wr * 64 + fr, c0 = u.pn * 256 + wc * 32 + fq * 8;
#pragma unroll
        for (int ai = 0; ai < 2; ++ai)
#pragma unroll
            for (int m = 0; m < 4; ++m) { const size_t o = (size_t)(row0 + ai * 128 + m * 16) * 2048 + c0; float ss = 0.f;
#pragma unroll
                for (int bj = 0; bj < 2; ++bj) {
                    const f32x4 v0 = acc[ai][bj][m][0] + *(const f32x4*)(x + o + bj * 128), v1 = acc[ai][bj][m][1] + *(const f32x4*)(x + o + bj * 128 + 4);
                    st8(x2 + o + bj * 128, v0, v1);
                    ss += (v0[0] * v0[0] + v0[1] * v0[1]) + (v0[2] * v0[2] + v0[3] * v0[3]) + (v1[0] * v1[0] + v1[1] * v1[1]) + (v1[2] * v1[2] + v1[3] * v1[3]); }
                ss += __shfl_xor(ss, 16); ss += __shfl_xor(ss, 32);
                if (fq == 0) ssqp[(size_t)(row0 + ai * 128 + m * 16) * 32 + u.pn * 4 + wc] = ss; }
    }
};

DI void moe_table(const Frame& F) {
    LAS int* tb = (LAS int*)(F.lds + LDS_TAB);
    if (F.tid < 32) tb[F.tid] = (int)__hip_atomic_load(F.ctl + CW_CNT + 64 * F.tid, __ATOMIC_RELAXED, __HIP_MEMORY_SCOPE_AGENT);
    __syncthreads();
    if (F.tid == 0) { int s = 0; for (int e = 0; e < 32; ++e) { tb[32 + e] = s; s += (tb[e] + 255) >> 8; } tb[64] = s; }
    __syncthreads();
    if (F.tid < 32) { const int b0 = tb[32 + F.tid], b1 = tb[33 + F.tid]; for (int b = b0; b < b1; ++b) tb[72 + b] = F.tid; }
    __syncthreads();
}

DI void p7_router(const Params& P, const Frame& F) {
    unsigned char* ws = P.ws;
    LAS float* part = (LAS float*)(F.lds + 512);
    constexpr int P7B = 512 + 65536;
    LAS float* rsl = (LAS float*)(F.lds + P7B + 3072);
    const bf16_t* x2 = (const bf16_t*)(ws + WS_X2); const float* gain = P.in[I_NORM_MOE];
    unsigned char* hn2 = ws + WS_HN2;
    const bf16_t* wrt = (const bf16_t*)(ws + WS_WRT);
    int* stok = (int*)(ws + WS_STOK); int* trec = (int*)(ws + WS_TREC);
    const int lane = F.lane, w = F.wave, tl = lane & 15, g = lane >> 4;
    for (int unit = F.bid; unit < NTOK / 64; unit += F.G) {
        const int t0 = unit * 64;
        { const f32x4 v = *(const f32x4*)((const float*)(ws + WS_SSQP) + (size_t)(t0 + 8 * w + (lane >> 3)) * 32 + (lane & 7) * 4);
          float ssq = (v[0] + v[1]) + (v[2] + v[3]); ssq += __shfl_xor(ssq, 1); ssq += __shfl_xor(ssq, 2); ssq += __shfl_xor(ssq, 4);
          if ((lane & 7) == 0) rsl[8 * w + (lane >> 3)] = __builtin_amdgcn_rsqf(ssq * (1.0f / 2048.0f) + NORM_EPS); }
        __syncthreads();
        {
            const bf16_t* xb = x2 + (size_t)(t0 + tl) * DM + 256 * w + 8 * g;
            const bf16_t* bh = wrt + (size_t)tl * DM + 256 * w + 8 * g; const bf16_t* bl = bh + NEXP * DM;
            const float* gp = gain + 256 * w + 8 * g;
            unsigned char* hp = hn2 + (size_t)(t0 + tl) * DM + 256 * w + 8 * g;
            float rs4[4];
#pragma unroll
            for (int tg = 0; tg < 4; ++tg) rs4[tg] = rsl[16 * tg + tl];
            f32x4 acc[4][2];
#pragma unroll
            for (int tg = 0; tg < 4; ++tg) { acc[tg][0] = (f32x4){0.f, 0.f, 0.f, 0.f}; acc[tg][1] = (f32x4){0.f, 0.f, 0.f, 0.f}; }
#pragma unroll 1
            for (int hf = 0; hf < 2; ++hf) {
                bf16x8 X[4][4], W[4][4]; f32x4 G[4][2];
#pragma unroll
                for (int ks = 0; ks < 4; ++ks) { const int o = 128 * hf + 32 * ks;
                    W[ks][0] = *(const bf16x8*)(bh + o); W[ks][1] = *(const bf16x8*)(bh + 16 * DM + o); W[ks][2] = *(const bf16x8*)(bl + o); W[ks][3] = *(const bf16x8*)(bl + 16 * DM + o);
                    G[ks][0] = *(const f32x4*)(gp + o); G[ks][1] = *(const f32x4*)(gp + o + 4);
#pragma unroll
                    for (int tg = 0; tg < 4; ++tg) X[ks][tg] = *(const bf16x8*)(xb + (size_t)(16 * tg) * DM + o); }
#pragma unroll
                for (int ks = 0; ks < 4; ++ks)
#pragma unroll
                    for (int tg = 0; tg < 4; ++tg) {
                        acc[tg][0] = __builtin_amdgcn_mfma_f32_16x16x32_bf16(X[ks][tg], W[ks][0], acc[tg][0], 0, 0, 0); acc[tg][1] = __builtin_amdgcn_mfma_f32_16x16x32_bf16(X[ks][tg], W[ks][1], acc[tg][1], 0, 0, 0);
                        acc[tg][0] = __builtin_amdgcn_mfma_f32_16x16x32_bf16(X[ks][tg], W[ks][2], acc[tg][0], 0, 0, 0); acc[tg][1] = __builtin_amdgcn_mfma_f32_16x16x32_bf16(X[ks][tg], W[ks][3], acc[tg][1], 0, 0, 0);
                        const u32x4 xq = __builtin_bit_cast(u32x4, X[ks][tg]); const float rs = rs4[tg]; u32x2 f8;
                        f8.x = pk4_fp8(bflo(xq.x) * rs * G[ks][0][0], bfhi(xq.x) * rs * G[ks][0][1], bflo(xq.y) * rs * G[ks][0][2], bfhi(xq.y) * rs * G[ks][0][3]);
                        f8.y = pk4_fp8(bflo(xq.z) * rs * G[ks][1][0], bfhi(xq.z) * rs * G[ks][1][1], bflo(xq.w) * rs * G[ks][1][2], bfhi(xq.w) * rs * G[ks][1][3]);
                        *(u32x2*)(hp + (size_t)(16 * tg) * DM + 128 * hf + 32 * ks) = f8;
                    }
            }
#pragma unroll
            for (int tg = 0; tg < 4; ++tg)
#pragma unroll
                for (int r = 0; r < 4; ++r) { part[(w * 64 + 16 * tg + 4 * g + r) * 32 + tl] = acc[tg][0][r]; part[(w * 64 + 16 * tg + 4 * g + r) * 32 + 16 + tl] = acc[tg][1][r]; }
        }
        __syncthreads();
        LAS int* sel_e = (LAS int*)(F.lds + P7B);
        LAS float* sel_w = (LAS float*)(F.lds + P7B + 1024);
        LAS int* lcnt = (LAS int*)(F.lds + P7B + 2048);
        if (F.tid < 32) lcnt[F.tid] = 0;
#pragma unroll 1
        for (int st = 0; st < 4; ++st) {
            const int tloc = 8 * w + 2 * st + (lane >> 5), e = lane & 31;
            float lsum = 0.f;
#pragma unroll
            for (int kq = 0; kq < 8; ++kq) lsum += part[(kq * 64 + tloc) * 32 + e];
            const float lg = P.in[I_BR][e] + rsl[tloc] * lsum;
            float cur = lg; float selv[4]; int sele[4];
#pragma unroll
            for (int k = 0; k < 4; ++k) {
                float bv = cur; int be = e;
#pragma unroll
                for (int o = 16; o > 0; o >>= 1) { const float ov = __shfl_xor(bv, o); const int oe = __shfl_xor(be, o); if (ov > bv || (ov == bv && oe < be)) { bv = ov; be = oe; } }
                selv[k] = bv; sele[k] = be; if (e == be) cur = -__builtin_inff();
            }
            const float m = selv[0]; float ex[4], s = 0.f;
#pragma unroll
            for (int k = 0; k < 4; ++k) { ex[k] = __expf(selv[k] - m); s += ex[k]; }
            const float inv = 1.0f / s;
            if (e < 4) {
                sel_e[tloc * 4 + e] = e == 0 ? sele[0] : (e == 1 ? sele[1] : (e == 2 ? sele[2] : sele[3]));
                sel_w[tloc * 4 + e] = (e == 0 ? ex[0] : (e == 1 ? ex[1] : (e == 2 ? ex[2] : ex[3]))) * inv;
            }
        }
        __syncthreads();
        int my_e = 0, my_lr = 0;
        if (F.tid < 256) { my_e = sel_e[F.tid]; my_lr = __hip_atomic_fetch_add(lcnt + my_e, 1, __ATOMIC_RELAXED, __HIP_MEMORY_SCOPE_WORKGROUP); }
        __syncthreads();
        if (F.tid < 32) { const int c = lcnt[F.tid]; lcnt[32 + F.tid] = c ? (int)__hip_atomic_fetch_add(F.ctl + CW_CNT + 64 * F.tid, (unsigned)c, __ATOMIC_RELAXED, __HIP_MEMORY_SCOPE_AGENT) : 0; }
        __syncthreads();
        if (F.tid < 256) {
            const int rank = lcnt[32 + my_e] + my_lr, tk = t0 + (F.tid >> 2);
            stok[(size_t)my_e * ECAP + rank] = tk;
            int* tr = trec + ((size_t)tk * 4 + (F.tid & 3)) * 4; tr[0] = my_e; tr[1] = rank; tr[2] = __float_as_int(sel_w[F.tid]); tr[3] = 0;
        }
        __syncthreads();
    }
}

struct SchedGU {
    static constexpr bool A_PER_UNIT = true;
    const char* hn2; const char* wgu; const int* stok; LAS int* tb; int G, c;
    DI bool next(int i, Unit& u) const { const int nblk = __builtin_amdgcn_readfirstlane(tb[64]); int blk, pn;
        { const int L = i * G + c; blk = L >> 4; pn = L & 15; }
        if (blk >= nblk) return false;
        const int e = __builtin_amdgcn_readfirstlane(tb[72 + blk]), r0 = (blk - __builtin_amdgcn_readfirstlane(tb[32 + e])) * 256;
        u.A = hn2; u.B = wgu + ((size_t)e * 4096 + pn * 256) * 2048; u.pm = blk; u.pn = pn; u.aux = e; u.rows = r0; u.keep = 0; return true; }
    DI void a_off(const Unit& u, const int (&R)[2], const int (&C)[2], unsigned (&v)[4]) const {
        const int ce = __builtin_amdgcn_readfirstlane(tb[u.aux]); const int* st = stok + (size_t)u.aux * ECAP;
#pragma unroll
        for (int h = 0; h < 2; ++h)
#pragma unroll
            for (int i = 0; i < 2; ++i) { int idx = u.rows + h * 128 + R[i]; idx = idx < ce ? idx : 0; v[h * 2 + i] = (unsigned)st[idx] * 2048u + (unsigned)C[i] * 2u; }
    }
};
struct EpiGU {
    unsigned char* act; const float* bgu;
    static constexpr bool PRE = true; LAS unsigned char* lds;
    DI void pre(const Unit& u, LAS unsigned char* slot) const {
        const int l = threadIdx.x & 63; const float* src = bgu + (size_t)u.aux * 4096 + u.pn * 128 + (l >> 5) * 2048 + (l & 31) * 4;
        __builtin_amdgcn_global_load_lds((const unsigned*)src, (LAS unsigned*)slot, 16, 0, 0); }
    static DI f32x4 swiglu(f32x4 g, f32x4 u) {
        f32x4 ga, ua;
#pragma unroll
        for (int i = 0; i < 4; ++i) { ga[i] = fminf(g[i], 7.0f); ua[i] = __builtin_amdgcn_fmed3f(u[i], -7.0f, 7.0f); }
        const f32x4 t = ga * (-1.702f * 1.4426950408889634f); f32x4 e;
#pragma unroll
        for (int i = 0; i < 4; ++i) e[i] = __builtin_amdgcn_exp2f(t[i]);
        const f32x4 d = e + 1.0f; f32x4 r;
#pragma unroll
        for (int i = 0; i < 4; ++i) r[i] = __builtin_amdgcn_rcpf(d[i]);
        return (ua + 1.0f) * (ga * r);
    }
    DI void operator()(const Acc& acc, const Unit& u, int wr, int wc, int fr, int fq) const {
        const int row0 = u.pm * 256 + wr * 64 + fr, x0 = u.pn * 128 + wc * 32 + fq * 8;
        const LAS float* bp = (const LAS float*)(lds + pg8::PRE_OFF + 1024 * u.par) + wc * 32 + fq * 8;
        const f32x4 bg0 = *(const LAS f32x4*)bp, bg1 = *(const LAS f32x4*)(bp + 4), bu0 = *(const LAS f32x4*)(bp + 128), bu1 = *(const LAS f32x4*)(bp + 132);
        float winv = W8_INV; asm volatile("" : "+v"(winv));
#pragma unroll
        for (int ai = 0; ai < 2; ++ai)
#pragma unroll
            for (int m = 0; m < 4; ++m) {
                const f32x4 o0 = swiglu(acc[ai][0][m][0] * winv + bg0, acc[ai][1][m][0] * winv + bu0), o1 = swiglu(acc[ai][0][m][1] * winv + bg1, acc[ai][1][m][1] * winv + bu1);
                u32x2 w8; w8.x = pk4_fp8(o0[0], o0[1], o0[2], o0[3]); w8.y = pk4_fp8(o1[0], o1[1], o1[2], o1[3]);
                *(u32x2*)(act + (size_t)(row0 + ai * 128 + m * 16) * 2048 + x0) = w8;
            }
    }
};
struct SchedDN {
    static constexpr bool A_PER_UNIT = false;
    const char* act; const char* wdn; LAS int* tb; int G, c;
    DI bool next(int i, Unit& u) const { const int nblk = __builtin_amdgcn_readfirstlane(tb[64]); int blk, pn;
        { const int L = i * G + c; blk = L >> 3; pn = L & 7; }
        if (blk >= nblk) return false;
        const int e = __builtin_amdgcn_readfirstlane(tb[72 + blk]);
        u.A = act + (size_t)blk * 256 * 2048; u.B = wdn + ((size_t)e * 2048 + pn * 256) * 2048; u.pm = blk; u.pn = pn; u.aux = e; u.rows = 256; u.keep = 0; return true; }
    DI void a_off(const Unit&, const int (&R)[2], const int (&C)[2], unsigned (&v)[4]) const {
#pragma unroll
        for (int h = 0; h < 2; ++h)
#pragma unroll
            for (int i = 0; i < 2; ++i) v[h * 2 + i] = (unsigned)(h * 128 + R[i]) * 2048u + (unsigned)C[i] * 2u; }
};
struct EpiDN {
    unsigned char* eo; const float* bdn;
    static constexpr bool PRE = true; LAS unsigned char* lds;
    DI void pre(const Unit& u, LAS unsigned char* slot) const {
        const int l = threadIdx.x & 63; __builtin_amdgcn_global_load_lds((const unsigned*)(bdn + (size_t)u.aux * 2048 + u.pn * 256 + l * 4), (LAS unsigned*)slot, 16, 0, 0); }
    DI void operator()(const Acc& acc, const Unit& u, int wr, int wc, int fr, int fq) const {
        const int row0 = u.pm * 256 + wr * 64 + fr, c0 = u.pn * 256 + wc * 32 + fq * 8;
        const LAS float* bp = (const LAS float*)(lds + pg8::PRE_OFF + 1024 * u.par) + wc * 32 + fq * 8;
        float winv = W8_INV; asm volatile("" : "+v"(winv));
        f32x4 bv[2][2];
#pragma unroll
        for (int bj = 0; bj < 2; ++bj)
#pragma unroll
            for (int n = 0; n < 2; ++n) bv[bj][n] = *(const LAS f32x4*)(bp + bj * 128 + 4 * n);
#pragma unroll
        for (int ai = 0; ai < 2; ++ai)
#pragma unroll
            for (int m = 0; m < 4; ++m) { unsigned char* rp = eo + (size_t)(row0 + ai * 128 + m * 16) * 2048 + c0;
#pragma unroll
                for (int bj = 0; bj < 2; ++bj) { const f32x4 v0 = acc[ai][bj][m][0] * winv + bv[bj][0], v1 = acc[ai][bj][m][1] * winv + bv[bj][1];
                    u32x2 w8; w8.x = pk4_fp8(v0[0], v0[1], v0[2], v0[3]); w8.y = pk4_fp8(v1[0], v1[1], v1[2], v1[3]); *(u32x2*)(rp + bj * 128) = w8; } }
    }
};
DI void p10_final(const Params& P, const Frame& F) {
    unsigned char* ws = P.ws; LAS int* tb = (LAS int*)(F.lds + LDS_TAB);
    const bf16_t* x2 = (const bf16_t*)(ws + WS_X2); const unsigned char* eo = ws + WS_EO; const int* trec = (const int*)(ws + WS_TREC);
    const float* gain = P.in[I_NORM_FINAL]; const int lane = F.lane;
    for (int tok = F.bid * 8 + F.wave; tok < NTOK; tok += F.G * 8) {
        const bf16_t* x = x2 + (size_t)tok * DM;
        f32x4 v[8];
#pragma unroll
        for (int i = 0; i < 8; ++i) { const u32x2 q = *(const u32x2*)(x + (i * 64 + lane) * 4); v[i] = (f32x4){bflo(q.x), bfhi(q.x), bflo(q.y), bfhi(q.y)}; }
#pragma unroll
        for (int k = 0; k < 4; ++k) {
            const int* tr = trec + ((size_t)tok * 4 + k) * 4; const int e = tr[0], rank = tr[1]; const float wv = __int_as_float(tr[2]);
            const unsigned char* er = eo + ((size_t)tb[32 + e] * 256 + rank) * 2048;
#pragma unroll
            for (int i = 0; i < 8; ++i) { const int q = *(const int*)(er + (i * 64 + lane) * 4);
                const f32x2 lo = __builtin_amdgcn_cvt_pk_f32_fp8(q, false), hi = __builtin_amdgcn_cvt_pk_f32_fp8(q, true);
                v[i][0] += wv * lo[0]; v[i][1] += wv * lo[1]; v[i][2] += wv * hi[0]; v[i][3] += wv * hi[1]; }
        }
        float ss = 0.f;
#pragma unroll
        for (int i = 0; i < 8; ++i) ss += v[i][0] * v[i][0] + v[i][1] * v[i][1] + v[i][2] * v[i][2] + v[i][3] * v[i][3];
        ss = wave_sum(ss); const float rs = __builtin_amdgcn_rsqf(ss * (1.0f / 2048.0f) + NORM_EPS);
        float* o = P.out + (size_t)tok * DM;
#pragma unroll
        for (int i = 0; i < 8; ++i) { const f32x4 g = *(const f32x4*)(gain + (i * 64 + lane) * 4); *(f32x4*)(o + (i * 64 + lane) * 4) = v[i] * rs * g; }
    }
}
typedef short v4i16_t __attribute__((ext_vector_type(4)));
DI s16x4 ld_tr(const LAS unsigned char* p) { return __builtin_bit_cast(s16x4, __builtin_amdgcn_ds_read_tr16_b64_v4i16((LAS v4i16_t*)p)); }
DI bf16x8 cat8(s16x4 a, s16x4 b) { return __builtin_shufflevector(a, b, 0, 1, 2, 3, 4, 5, 6, 7); }

struct SchedCmp {
    static constexpr bool A_PER_UNIT = false;
    unsigned char* ws; int G, c;
    DI bool next(int i, Unit& u) const { const int L = c; if (i > 0 || L >= 256) return false;
        const int kv = L >> 7, pm = (L >> 4) & 7, s = L & 15;
        u.A = (const char*)(ws + WS_KV + (size_t)kv * KV_STRIDE) + s * 512; u.B = (const char*)(ws + (kv ? WS_WCV1 : WS_WCK1)) + s * 512; u.pm = pm; u.pn = 0; u.aux = kv * 16 + s; u.rows = 256; u.keep = 0; return true; }
    DI void a_off(const Unit& u, const int (&R)[2], const int (&C)[2], unsigned (&v)[4]) const {
#pragma unroll
        for (int h = 0; h < 2; ++h)
#pragma unroll
            for (int i = 0; i < 2; ++i) { int r = u.pm * 256 + h * 128 + R[i]; r = r < 2032 ? r : 2031; const int bg = r / 127, n = r - bg * 127;
                v[h * 2 + i] = (unsigned)((bg * SEQ + n * 16) * 128 + C[i]) * 2u; }
    }
};
struct EpiCmp {
    bf16_t* part;
    DI void operator()(const Acc& acc, const Unit& u, int wr, int wc, int fr, int fq) const {
        const int row0 = u.pm * 256 + wr * 64 + fr, x0 = wc * 32 + fq * 8;
#pragma unroll
        for (int ai = 0; ai < 2; ++ai)
#pragma unroll
            for (int m = 0; m < 4; ++m) { bf16_t* rp = part + ((size_t)u.aux * 2048 + row0 + ai * 128 + m * 16) * 256 + x0;
#pragma unroll
                for (int bj = 0; bj < 2; ++bj) st8(rp + bj * 128, acc[ai][bj][m][0], acc[ai][bj][m][1]); }
    }
};
DI float gelu_tanh(float x) { const float y = 0.7978845608028654f * (x + 0.044715f * x * x * x); const float t = 1.0f - 2.0f * __builtin_amdgcn_rcpf(1.0f + __expf(2.0f * y)); return 0.5f * x * (1.0f + t); }
DI void cmp_stage2(const Params& P, const Frame& F) {
    unsigned char* ws = P.ws; LAS float* hid = (LAS float*)F.lds;
    const bf16_t* part = (const bf16_t*)(ws + WS_CPART); const float* cb = (const float*)(ws + WS_CBIAS);
    bf16_t* kc = (bf16_t*)(ws + WS_KCMP);
    if (F.bid < 32 && F.tid < 128) kc[((size_t)F.bid * 128 + 127) * 128 + F.tid] = 0;
    for (int blk = F.bid; blk < 254; blk += F.G) {
        const int kv = blk >= 127, r0 = (blk - kv * 127) * 16;
        {
            const int c = F.tid & 255, rr0 = F.tid >> 8; float bsum = 0.f;
            for (int ch = 0; ch < 32; ++ch) bsum += cb[ch * 512 + kv * 256 + c];
#pragma unroll
            for (int q = 0; q < 8; ++q) { const int rr = rr0 + 2 * q; float s = bsum;
#pragma unroll
                for (int sp = 0; sp < 16; ++sp) s += bf2f(part[((size_t)(kv * 16 + sp) * 2048 + r0 + rr) * 256 + c]);
                hid[rr * 256 + c] = gelu_tanh(s); }
        }
        __syncthreads();
        {
            const int c = F.tid & 127, rg = F.tid >> 7; const float* w2 = P.in[kv ? I_WCV2 : I_WCK2];
            float a[4] = {0.f, 0.f, 0.f, 0.f};
#pragma unroll 4
            for (int k = 0; k < 256; ++k) { const float w = w2[k * 128 + c];
#pragma unroll
                for (int j = 0; j < 4; ++j) a[j] += hid[(rg * 4 + j) * 256 + k] * w; }
#pragma unroll
            for (int j = 0; j < 4; ++j) { const int r = r0 + rg * 4 + j; const int bg = r / 127, n = r - bg * 127; kc[(((size_t)kv * 16 + bg) * 128 + n) * 128 + c] = f2bf(a[j]); }
        }
        __syncthreads();
    }
}

constexpr int GP_STRIDE = 272;
DI void gla_prep(const Params& P, const Frame& F) {
    unsigned char* ws = P.ws;
    constexpr int GP_U = 2 * 64 * GP_STRIDE + 8192;
    const float* small = (const float*)(ws + WS_SMALL); const bf16_t* qg = (const bf16_t*)(ws + WS_QG); const bf16_t* kg = (const bf16_t*)(ws + WS_KG);
    bf16_t* gqt = (bf16_t*)(ws + WS_GQT); bf16_t* gks = (bf16_t*)(ws + WS_GKS); bf16_t* gatt = (bf16_t*)(ws + WS_GATT); float* gdec = (float*)(ws + WS_GDEC);
    const int d = 2 * (F.tid & 63), tg = F.tid >> 6, lane = F.lane, w = F.wave;
    for (int unit0 = 2 * F.bid; unit0 < NB * GLA_H * GNC; unit0 += 2 * F.G) {
        const int n0 = unit0 & 31, h = (unit0 >> 5) & 3, b = unit0 >> 7;
        f32x2 wa[16];
#pragma unroll
        for (int r = 0; r < 16; ++r) wa[r] = *(const f32x2*)(P.in[I_WGA] + r * 512 + h * 128 + d);
        const f32x2 ba = *(const f32x2*)(P.in[I_BGA] + h * 128 + d);
        f32x2 cl[2][8]; unsigned qk[2][8][2]; f32x2 ain[2];
#pragma unroll
        for (int u = 0; u < 2; ++u) { const int tok0 = b * SEQ + (n0 + u) * 64 + tg * 8;
            ain[u] = *(const f32x2*)(small + (size_t)(b * SEQ + (n0 + u) * 64 + (F.tid >> 3)) * 64 + 24 + 2 * (F.tid & 7));
#pragma unroll
            for (int j = 0; j < 8; ++j) { qk[u][j][0] = *(const unsigned*)(qg + (size_t)(tok0 + j) * 512 + h * 128 + d); qk[u][j][1] = *(const unsigned*)(kg + (size_t)(tok0 + j) * 512 + h * 128 + d); } }
#pragma unroll
        for (int u = 0; u < 2; ++u) *(LAS f32x2*)((LAS float*)(F.lds + u * GP_U + 2 * 64 * GP_STRIDE + 4096) + (F.tid >> 3) * 16 + 2 * (F.tid & 7)) = ain[u];
        __syncthreads();
#pragma unroll
        for (int u = 0; u < 2; ++u) { f32x2 run = {0.f, 0.f};
#pragma unroll
            for (int j = 0; j < 8; ++j) { f32x2 z = ba;
#pragma unroll
                for (int r4 = 0; r4 < 4; ++r4) { const f32x4 a4 = *(const LAS f32x4*)((const LAS float*)(F.lds + u * GP_U + 2 * 64 * GP_STRIDE + 4096) + (tg * 8 + j) * 16 + 4 * r4); z += wa[4 * r4] * a4[0] + wa[4 * r4 + 1] * a4[1] + wa[4 * r4 + 2] * a4[2] + wa[4 * r4 + 3] * a4[3]; }
                f32x2 ls; ls.x = fminf(z.x, 0.f) - __logf(1.0f + __expf(-fabsf(z.x))); ls.y = fminf(z.y, 0.f) - __logf(1.0f + __expf(-fabsf(z.y)));
                run += ls * (1.0f / 16.0f); cl[u][j] = run; }
            *(LAS f32x2*)((LAS float*)(F.lds + u * GP_U + 2 * 64 * GP_STRIDE) + tg * 128 + d) = run; }
        __syncthreads();
#pragma unroll
        for (int u = 0; u < 2; ++u) { const int unit = unit0 + u;
            LAS unsigned char* Ql = F.lds + u * GP_U; LAS unsigned char* Kl = Ql + 64 * GP_STRIDE; const LAS float* tot = (const LAS float*)(Ql + 2 * 64 * GP_STRIDE);
            f32x2 off = {0.f, 0.f}, last = {0.f, 0.f};
#pragma unroll
            for (int g = 0; g < 8; ++g) { const f32x2 tv = *(const LAS f32x2*)(tot + g * 128 + d); if (g < tg) off += tv; last += tv; }
            if (tg == 0) { f32x2 dv; dv.x = __expf(last.x); dv.y = __expf(last.y); *(f32x2*)(gdec + (size_t)unit * 128 + d) = dv; }
#pragma unroll
            for (int j = 0; j < 8; ++j) {
                const int sl = tg * 8 + j; const f32x2 cum = off + cl[u][j];
                const float q0 = bflo(qk[u][j][0]), q1 = bfhi(qk[u][j][0]), k0 = bflo(qk[u][j][1]), k1 = bfhi(qk[u][j][1]);
                const unsigned qt = cvt_pk_bf16(q0 * 0.08838834764831845f * __expf(cum.x), q1 * 0.08838834764831845f * __expf(cum.y));
                const unsigned kt = cvt_pk_bf16(k0 * __expf(-cum.x), k1 * __expf(-cum.y));
                const unsigned ks = cvt_pk_bf16(k0 * __expf(last.x - cum.x), k1 * __expf(last.y - cum.y));
                const size_t o = ((size_t)(b * GLA_H + h) * SEQ + (n0 + u) * 64 + sl) * 128 + d;
                *(unsigned*)(gqt + o) = qt; *(unsigned*)(gks + o) = ks;
                *(LAS unsigned*)(Ql + sl * GP_STRIDE + d * 2) = qt; *(LAS unsigned*)(Kl + sl * GP_STRIDE + d * 2) = kt;
            } }
        __syncthreads();
#pragma unroll
        for (int u = 0; u < 2; ++u) { const int unit = unit0 + u; const LAS unsigned char* Ql = F.lds + u * GP_U; const LAS unsigned char* Kl = Ql + 64 * GP_STRIDE;
#pragma unroll
            for (int q = 0; q < 2; ++q) {
                const int blk = 2 * w + q, bi = blk >> 2, bc = blk & 3, r = lane & 15, g = lane >> 4;
                f32x4 acc = {0.f, 0.f, 0.f, 0.f};
                if (bc <= bi) {
#pragma unroll
                    for (int ks = 0; ks < 4; ++ks) {
                        const bf16x8 a = *(const LAS bf16x8*)(Ql + (bi * 16 + r) * GP_STRIDE + (32 * ks + 8 * g) * 2);
                        const bf16x8 bb = *(const LAS bf16x8*)(Kl + (bc * 16 + r) * GP_STRIDE + (32 * ks + 8 * g) * 2);
                        acc = __builtin_amdgcn_mfma_f32_16x16x32_bf16(a, bb, acc, 0, 0, 0);
                    }
                }
                const int jcol = bc * 16 + r;
#pragma unroll
                for (int rg = 0; rg < 4; ++rg) { const int irow = bi * 16 + 4 * g + rg; gatt[((size_t)unit * 64 + irow) * 64 + jcol] = (jcol <= irow) ? f2bf(acc[rg]) : (bf16_t)0; }
            } }
        __syncthreads();
    }
}

constexpr int GS_QT = 0, GS_KS = 64 * 272, GS_ATT = 2 * 64 * 272, GS_V = GS_ATT + 64 * 144, GS_S = GS_V + 64 * 72, GS_GO = GS_S + 128 * 72, GS_END = GS_GO + 64 * 144;
DI void gla_scan(const Params& P, const Frame& F) {
    unsigned char* ws = P.ws; LAS unsigned char* L = F.lds;
    const bf16_t* gqt = (const bf16_t*)(ws + WS_GQT); const bf16_t* gks = (const bf16_t*)(ws + WS_GKS); const bf16_t* gatt = (const bf16_t*)(ws + WS_GATT);
    const bf16_t* vg = (const bf16_t*)(ws + WS_VG); const float* gdec = (const float*)(ws + WS_GDEC); float* go = (float*)(ws + WS_GO);
    const int tid = F.tid, lane = F.lane, w = F.wave, r = lane & 15, g = lane >> 4, q4 = (lane & 15) >> 2, p4 = lane & 3;
    for (int unit = F.bid; unit < NB * GLA_H * 8; unit += F.G) {
        const int dvs = unit & 7, h = (unit >> 3) & 3, b = unit >> 5;
        const size_t bh = (size_t)(b * GLA_H + h);
        f32x4 S0 = {0.f, 0.f, 0.f, 0.f}, S1 = {0.f, 0.f, 0.f, 0.f};
        for (int i = tid; i < 128 * 72 / 4; i += 512) ((LAS unsigned*)(L + GS_S))[i] = 0u;
        u32x4 rqA[2], rkA[2], raA, rvA, rqB[2], rkB[2], raB, rvB;
#define GS_LOAD(nn_, rq, rk, ra, rv) do { const int n_ = (nn_) < GNC ? (nn_) : GNC - 1; const size_t t0_ = (bh * SEQ + (n_) * 64) * 128; \
            _Pragma("unroll") for (int i_ = 0; i_ < 2; ++i_) { const int id_ = tid + 512 * i_; rq[i_] = *(const u32x4*)(gqt + t0_ + (size_t)id_ * 8); rk[i_] = *(const u32x4*)(gks + t0_ + (size_t)id_ * 8); } \
            ra = *(const u32x4*)(gatt + ((bh * GNC + (n_)) * 64) * 64 + (size_t)tid * 8); \
            rv = *(const u32x4*)(vg + ((size_t)(b * SEQ + (n_) * 64 + ((tid & 255) >> 2))) * 1024 + h * 256 + dvs * 32 + (tid & 3) * 8); } while (0)
#define GS_STORE(rq, rk, ra, rv) do { _Pragma("unroll") for (int i_ = 0; i_ < 2; ++i_) { const int id_ = tid + 512 * i_; \
                *(LAS u32x4*)(L + GS_QT + (id_ >> 4) * 272 + (id_ & 15) * 16) = rq[i_]; *(LAS u32x4*)(L + GS_KS + (id_ >> 4) * 272 + (id_ & 15) * 16) = rk[i_]; } \
            *(LAS u32x4*)(L + GS_ATT + (tid >> 3) * 144 + (tid & 7) * 16) = ra; \
            if (tid < 256) { *(LAS u32x2*)(L + GS_V + (tid >> 2) * 72 + (tid & 3) * 16) = (u32x2){rv.x, rv.y}; *(LAS u32x2*)(L + GS_V + (tid >> 2) * 72 + (tid & 3) * 16 + 8) = (u32x2){rv.z, rv.w}; } } while (0)
#define GS_CHUNK(n) do { \
            const f32x4 dec = decn; decn = *(const f32x4*)(gdec + ((bh * GNC + ((n) + 1 < GNC ? (n) + 1 : (n))) * 128) + 16 * w + 4 * g); \
            const int bi = w >> 1, bc = w & 1; \
            f32x4 o = {0.f, 0.f, 0.f, 0.f}; \
            _Pragma("unroll") for (int ks = 0; ks < 2; ++ks) { \
                const bf16x8 a = *(const LAS bf16x8*)(L + GS_ATT + (bi * 16 + r) * 144 + (32 * ks + 8 * g) * 2); \
                const LAS unsigned char* vp = L + GS_V + (32 * ks + 8 * g + q4) * 72 + (bc * 16 + 4 * p4) * 2; \
                const bf16x8 bb = cat8(ld_tr(vp), ld_tr(vp + 4 * 72)); \
                o = __builtin_amdgcn_mfma_f32_16x16x32_bf16(a, bb, o, 0, 0, 0); } \
            _Pragma("unroll") for (int ks = 0; ks < 4; ++ks) { \
                const bf16x8 a = *(const LAS bf16x8*)(L + GS_QT + (bi * 16 + r) * 272 + (32 * ks + 8 * g) * 2); \
                const LAS unsigned char* sp = L + GS_S + (32 * ks + 8 * g + q4) * 72 + (bc * 16 + 4 * p4) * 2; \
                const bf16x8 bb = cat8(ld_tr(sp), ld_tr(sp + 4 * 72)); \
                o = __builtin_amdgcn_mfma_f32_16x16x32_bf16(a, bb, o, 0, 0, 0); } \
            f32x4 n0 = S0 * dec, n1 = S1 * dec; \
            _Pragma("unroll") for (int ks = 0; ks < 2; ++ks) { \
                const LAS unsigned char* kp = L + GS_KS + (32 * ks + 8 * g + q4) * 272 + (16 * w + 4 * p4) * 2; \
                const bf16x8 a = cat8(ld_tr(kp), ld_tr(kp + 4 * 272)); \
                const LAS unsigned char* vp0 = L + GS_V + (32 * ks + 8 * g + q4) * 72 + (4 * p4) * 2; \
                const bf16x8 b0 = cat8(ld_tr(vp0), ld_tr(vp0 + 4 * 72)), b1 = cat8(ld_tr(vp0 + 32), ld_tr(vp0 + 32 + 4 * 72)); \
                n0 = __builtin_amdgcn_mfma_f32_16x16x32_bf16(a, b0, n0, 0, 0, 0); \
                n1 = __builtin_amdgcn_mfma_f32_16x16x32_bf16(a, b1, n1, 0, 0, 0); } \
            S0 = n0; S1 = n1; \
            _Pragma("unroll") for (int rg = 0; rg < 4; ++rg) *(LAS float*)(L + GS_GO + ((bi * 16 + 4 * g + rg) * 36 + bc * 16 + r) * 4) = o[rg]; \
            LDS_BARRIER(); \
            *(f32x4*)(go + ((size_t)(b * SEQ + (n) * 64 + (tid >> 3))) * 1024 + h * 256 + dvs * 32 + (tid & 7) * 4) = *(const LAS f32x4*)(L + GS_GO + ((tid >> 3) * 36 + (tid & 7) * 4) * 4);       \
            _Pragma("unroll") for (int rg = 0; rg < 4; ++rg) { *(LAS bf16_t*)(L + GS_S + (16 * w + 4 * g + rg) * 72 + r * 2) = f2bf(S0[rg]); *(LAS bf16_t*)(L + GS_S + (16 * w + 4 * g + rg) * 72 + (16 + r) * 2) = f2bf(S1[rg]); } } while (0)
        f32x4 decn = *(const f32x4*)(gdec + ((bh * GNC + 0) * 128) + 16 * w + 4 * g);
        GS_LOAD(0, rqA, rkA, raA, rvA); GS_LOAD(1, rqB, rkB, raB, rvB);
        LDS_BARRIER();
        GS_STORE(rqA, rkA, raA, rvA);
        for (int n = 0; n < GNC; n += 2) {
            LDS_BARRIER();
            GS_LOAD(n + 2, rqA, rkA, raA, rvA);
            GS_CHUNK(n);
            GS_STORE(rqB, rkB, raB, rvB);
            LDS_BARRIER();
            GS_LOAD(n + 3, rqB, rkB, raB, rvB);
            GS_CHUNK(n + 1);
            GS_STORE(rqA, rkA, raA, rvA);
        }
        LDS_BARRIER();
#undef GS_LOAD
#undef GS_STORE
#undef GS_CHUNK
    }
}
constexpr int G2_QT = 0, G2_KS = 64 * 272, G2_ATT = 2 * 64 * 272, G2_V = G2_ATT + 64 * 144, G2_DEC = G2_V + 64 * 72, G2_BUF = G2_DEC + 512;
DI void gla_scan2(const Params& P, const Frame& F) {
    unsigned char* ws = P.ws; LAS unsigned char* L = F.lds;
    const bf16_t* gqt = (const bf16_t*)(ws + WS_GQT); const bf16_t* gks = (const bf16_t*)(ws + WS_GKS); const bf16_t* gatt = (const bf16_t*)(ws + WS_GATT);
    const bf16_t* vg = (const bf16_t*)(ws + WS_VG); const float* gdec = (const float*)(ws + WS_GDEC); float* go = (float*)(ws + WS_GO);
    const int tid = F.tid, lane = F.lane, w = F.wave, r = lane & 15, g = lane >> 4, q4 = (lane & 15) >> 2, p4 = lane & 3, cw = w & 1, rh = w >> 1;
    for (int u0 = F.bid; u0 < NB * GLA_H * 8; u0 += F.G) {
        const int unit = (F.G == 256) ? (((u0 & 7) * 4 + (u0 >> 6)) * 8 + ((u0 >> 3) & 7)) : u0;
        const int dvs = unit & 7, h = (unit >> 3) & 3, b = unit >> 5;
        const size_t bh = (size_t)(b * GLA_H + h);
        f32x4 S[8];
#pragma unroll
        for (int kb = 0; kb < 8; ++kb) S[kb] = (f32x4){0.f, 0.f, 0.f, 0.f};
        u32x4 rqA[2], rkA[2], raA, rvA, rdA, rqB[2], rkB[2], raB, rvB, rdB, rqC[2], rkC[2], raC, rvC, rdC, rqD[2], rkD[2], raD, rvD, rdD;
#define G2_LOAD(nn_, rq, rk, ra, rv, rd) do { const int n_ = (nn_) < GNC ? (nn_) : GNC - 1; const size_t t0_ = (bh * SEQ + (n_) * 64) * 128; \
            _Pragma("unroll") for (int i_ = 0; i_ < 2; ++i_) { const int id_ = tid + 512 * i_; rq[i_] = *(const u32x4*)(gqt + t0_ + (size_t)id_ * 8); rk[i_] = *(const u32x4*)(gks + t0_ + (size_t)id_ * 8); } \
            ra = *(const u32x4*)(gatt + ((bh * GNC + (n_)) * 64) * 64 + (size_t)tid * 8); \
            rv = *(const u32x4*)(vg + ((size_t)(b * SEQ + (n_) * 64 + ((tid & 255) >> 2))) * 1024 + h * 256 + dvs * 32 + (tid & 3) * 8); \
            rd = *(const u32x4*)(gdec + ((bh * GNC + (n_)) * 128) + (tid & 31) * 4); } while (0)
#define G2_STORE(Lb, rq, rk, ra, rv, rd) do { _Pragma("unroll") for (int i_ = 0; i_ < 2; ++i_) { const int id_ = tid + 512 * i_; \
                *(LAS u32x4*)((Lb) + G2_QT + (id_ >> 4) * 272 + (id_ & 15) * 16) = rq[i_]; *(LAS u32x4*)((Lb) + G2_KS + (id_ >> 4) * 272 + (id_ & 15) * 16) = rk[i_]; } \
            *(LAS u32x4*)((Lb) + G2_ATT + (tid >> 3) * 144 + (tid & 7) * 16) = ra; \
            if (tid < 256) { *(LAS u32x2*)((Lb) + G2_V + (tid >> 2) * 72 + (tid & 3) * 16) = (u32x2){rv.x, rv.y}; *(LAS u32x2*)((Lb) + G2_V + (tid >> 2) * 72 + (tid & 3) * 16 + 8) = (u32x2){rv.z, rv.w}; } \
            if (tid < 32) *(LAS u32x4*)((Lb) + G2_DEC + tid * 16) = rd; } while (0)
#define G2_COMPUTE(n, Lb) do { \
            bf16x8 sf[4], vf[2]; \
            _Pragma("unroll") for (int ks = 0; ks < 4; ++ks) { u32x4 pk; pk.x = cvt_pk_bf16(S[2 * ks][0], S[2 * ks][1]); pk.y = cvt_pk_bf16(S[2 * ks][2], S[2 * ks][3]); \
                pk.z = cvt_pk_bf16(S[2 * ks + 1][0], S[2 * ks + 1][1]); pk.w = cvt_pk_bf16(S[2 * ks + 1][2], S[2 * ks + 1][3]); sf[ks] = __builtin_bit_cast(bf16x8, pk); } \
            _Pragma("unroll") for (int ks = 0; ks < 2; ++ks) { const LAS unsigned char* vp = (Lb) + G2_V + (32 * ks + 8 * g + q4) * 72 + (cw * 16 + 4 * p4) * 2; vf[ks] = cat8(ld_tr(vp), ld_tr(vp + 4 * 72)); } \
            _Pragma("unroll") for (int bb = 0; bb < 2; ++bb) { const int bi = 2 * rh + bb; f32x4 o = {0.f, 0.f, 0.f, 0.f}; \
                _Pragma("unroll") for (int ks = 0; ks < 2; ++ks) { const bf16x8 a = *(const LAS bf16x8*)((Lb) + G2_ATT + (bi * 16 + r) * 144 + (32 * ks + 8 * g) * 2); o = __builtin_amdgcn_mfma_f32_16x16x32_bf16(a, vf[ks], o, 0, 0, 0); } \
                _Pragma("unroll") for (int ks = 0; ks < 4; ++ks) { const LAS unsigned char* qp = (Lb) + G2_QT + (bi * 16 + r) * 272 + (32 * ks + 4 * g) * 2; \
                    const bf16x8 a = cat8(*(const LAS s16x4*)qp, *(const LAS s16x4*)(qp + 32)); o = __builtin_amdgcn_mfma_f32_16x16x32_bf16(a, sf[ks], o, 0, 0, 0); } \
                _Pragma("unroll") for (int rg = 0; rg < 4; ++rg) go[((size_t)(b * SEQ + (n) * 64 + bi * 16 + 4 * g + rg)) * 1024 + h * 256 + dvs * 32 + cw * 16 + r] = o[rg]; } \
            _Pragma("unroll") for (int kb = 0; kb < 8; ++kb) { const f32x4 dec = *(const LAS f32x4*)((Lb) + G2_DEC + (16 * kb + 4 * g) * 4); f32x4 nn = S[kb] * dec; \
                _Pragma("unroll") for (int ks = 0; ks < 2; ++ks) { const LAS unsigned char* kp = (Lb) + G2_KS + (32 * ks + 8 * g + q4) * 272 + (16 * kb + 4 * p4) * 2; \
                    nn = __builtin_amdgcn_mfma_f32_16x16x32_bf16(cat8(ld_tr(kp), ld_tr(kp + 4 * 272)), vf[ks], nn, 0, 0, 0); } \
                S[kb] = nn; } } while (0)
        G2_LOAD(0, rqA, rkA, raA, rvA, rdA); G2_LOAD(1, rqB, rkB, raB, rvB, rdB); G2_LOAD(2, rqC, rkC, raC, rvC, rdC); G2_LOAD(3, rqD, rkD, raD, rvD, rdD);
        G2_STORE(L, rqA, rkA, raA, rvA, rdA);
        for (int n = 0; n < GNC; n += 4) {
            __syncthreads(); G2_LOAD(n + 4, rqA, rkA, raA, rvA, rdA); G2_STORE(L + G2_BUF, rqB, rkB, raB, rvB, rdB); if (w < 4) G2_COMPUTE(n, L);
            __syncthreads(); G2_LOAD(n + 5, rqB, rkB, raB, rvB, rdB); G2_STORE(L, rqC, rkC, raC, rvC, rdC);          if (w < 4) G2_COMPUTE(n + 1, L + G2_BUF);
            __syncthreads(); G2_LOAD(n + 6, rqC, rkC, raC, rvC, rdC); G2_STORE(L + G2_BUF, rqD, rkD, raD, rvD, rdD); if (w < 4) G2_COMPUTE(n + 2, L);
            __syncthreads(); G2_LOAD(n + 7, rqD, rkD, raD, rvD, rdD); G2_STORE(L, rqA, rkA, raA, rvA, rdA);          if (w < 4) G2_COMPUTE(n + 3, L + G2_BUF);
        }
        __syncthreads();
#undef G2_LOAD
#undef G2_STORE
#undef G2_COMPUTE
    }
}
DI void gla_post(const Params& P, const Frame& F) {
    unsigned char* ws = P.ws; const float* go = (const float*)(ws + WS_GO); const bf16_t* rg = (const bf16_t*)(ws + WS_RG); bf16_t* og = (bf16_t*)(ws + WS_ONSA) + 1024; const float* gain = P.in[I_GLA_NORM];
    const int lane = F.lane;
    f32x4 gn[4];
#pragma unroll
    for (int i = 0; i < 4; ++i) gn[i] = *(const f32x4*)(gain + (i * 64 + lane) * 4);
    for (int tok = F.bid * 16 + F.wave * 2; tok < NTOK; tok += F.G * 16) {
        f32x4 v[2][4]; u32x2 rr[2][4];
#pragma unroll
        for (int t = 0; t < 2; ++t)
#pragma unroll
            for (int i = 0; i < 4; ++i) { const int c = (i * 64 + lane) * 4; v[t][i] = *(const f32x4*)(go + (size_t)(tok + t) * 1024 + c); rr[t][i] = *(const u32x2*)(rg + (size_t)(tok + t) * 1024 + c); }
        u32x2 o[2][4];
#pragma unroll
        for (int t = 0; t < 2; ++t)
#pragma unroll
            for (int i = 0; i < 4; ++i) {
                const f32x4 x = v[t][i]; float ss = x[0] * x[0] + x[1] * x[1] + x[2] * x[2] + x[3] * x[3]; ss = wave_sum(ss);
                const float rs = __builtin_amdgcn_rsqf(ss * (1.0f / 256.0f) + NORM_EPS);
                const float r0 = bflo(rr[t][i].x), r1 = bfhi(rr[t][i].x), r2 = bflo(rr[t][i].y), r3 = bfhi(rr[t][i].y);
                o[t][i].x = cvt_pk_bf16(x[0] * rs * gn[i][0] * r0 * fast_sigmoid(r0), x[1] * rs * gn[i][1] * r1 * fast_sigmoid(r1));
                o[t][i].y = cvt_pk_bf16(x[2] * rs * gn[i][2] * r2 * fast_sigmoid(r2), x[3] * rs * gn[i][3] * r3 * fast_sigmoid(r3)); }
#pragma unroll
        for (int t = 0; t < 2; ++t)
#pragma unroll
            for (int i = 0; i < 4; ++i) *(u32x2*)(og + (size_t)(tok + t) * 2048 + (i * 64 + lane) * 4) = o[t][i];
    }
}
constexpr int KSTR = 272, VSTR = 320;
constexpr int AT_K = 0, AT_V = 64 * KSTR, AT_BUF = 64 * KSTR + 64 * VSTR, AT_IMP = 2 * AT_BUF, AT_SELM = AT_IMP + 4 * 64 * 32 * 4, AT_END = AT_SELM + 512;
constexpr float AT_C2 = 0.08838834764831845f * 1.4426950408889634f;
DI float xmax32(float x) { auto rr = __builtin_amdgcn_permlane32_swap(__float_as_uint(x), __float_as_uint(x), false, false); return fmaxf(__uint_as_float(rr[0]), __uint_as_float(rr[1])); }
DI float xsum32(float x) { auto rr = __builtin_amdgcn_permlane32_swap(__float_as_uint(x), __float_as_uint(x), false, false); return __uint_as_float(rr[0]) + __uint_as_float(rr[1]); }
DI float xget32(float x, int hi) { auto rr = __builtin_amdgcn_permlane32_swap(__float_as_uint(x), __float_as_uint(x), false, false); return __uint_as_float(hi ? rr[0] : rr[1]); }
#define MFMA32(a, b, c) __builtin_amdgcn_mfma_f32_32x32x16_bf16((a), (b), (c), 0, 0, 0)

DI void at_load(u32x4 (&rk)[2], u32x4 (&rv)[2], const bf16_t* Kb, const bf16_t* Vb, int key0, int tid) {
#pragma unroll
    for (int i = 0; i < 2; ++i) { const size_t o = (size_t)key0 * 128 + (size_t)(tid + 512 * i) * 8; rk[i] = *(const u32x4*)(Kb + o); rv[i] = *(const u32x4*)(Vb + o); }
}
DI void at_store(LAS unsigned char* L, const u32x4 (&rk)[2], const u32x4 (&rv)[2], int tid) {
#pragma unroll
    for (int i = 0; i < 2; ++i) { const int id = tid + 512 * i; *(LAS u32x4*)(L + AT_K + (id >> 4) * KSTR + (id & 15) * 16) = rk[i]; *(LAS u32x4*)(L + AT_V + (id >> 4) * VSTR + (id & 15) * 16) = rv[i]; }
}
DI void at_qk(f32x16& p0, f32x16& p1, const LAS unsigned char* L, const bf16x8 (&qr)[8], int r32, int hi) {
#pragma unroll
    for (int r = 0; r < 16; ++r) { p0[r] = 0.f; p1[r] = 0.f; }
    const LAS unsigned char* kb = L + AT_K + r32 * KSTR + hi * 16;
#pragma unroll
    for (int ks = 0; ks < 8; ++ks) {
        const bf16x8 a0 = *(const LAS bf16x8*)(kb + ks * 32), a1 = *(const LAS bf16x8*)(kb + 32 * KSTR + ks * 32);
        p0 = MFMA32(a0, qr[ks], p0); p1 = MFMA32(a1, qr[ks], p1);
    }
}
DI bf16x8 at_pack(const f32x16& x, const int s) {
    u32x4 w; w.x = cvt_pk_bf16(x[8 * s + 0], x[8 * s + 1]); w.y = cvt_pk_bf16(x[8 * s + 2], x[8 * s + 3]); w.z = cvt_pk_bf16(x[8 * s + 4], x[8 * s + 5]); w.w = cvt_pk_bf16(x[8 * s + 6], x[8 * s + 7]);
    return __builtin_bit_cast(bf16x8, w);
}
DI void at_pv(f32x16 (&o)[4], const LAS unsigned char* L, const f32x16& p0, const f32x16& p1, int lane) {
    const int hi = lane >> 5, q4 = (lane & 15) >> 2, p4 = lane & 3;
    const LAS unsigned char* vb = L + AT_V + (4 * hi + q4) * VSTR + (16 * ((lane >> 4) & 1) + 4 * p4) * 2;
#pragma unroll
    for (int s = 0; s < 4; ++s) {
        const bf16x8 pf = (s < 2) ? at_pack(p0, s & 1) : at_pack(p1, s & 1);
#pragma unroll
        for (int nb = 0; nb < 4; ++nb) {
            const s16x4 lo = ld_tr(vb + (16 * s) * VSTR + nb * 64), h8 = ld_tr(vb + (16 * s + 8) * VSTR + nb * 64);
            o[nb] = MFMA32(cat8(lo, h8), pf, o[nb]);
        }
    }
}
DI float at_softmax(f32x16& p0, f32x16& p1, float& m, float& l, f32x16 (&o)[4], bool dead = false) {
    float pmax = p0[0];
#pragma unroll
    for (int r = 1; r < 16; ++r) pmax = fmaxf(pmax, p0[r]);
#pragma unroll
    for (int r = 0; r < 16; ++r) pmax = fmaxf(pmax, p1[r]);
    pmax = xmax32(pmax); pmax = dead ? -__builtin_inff() : pmax;
    const bool keep = __all((pmax - m) * AT_C2 <= 11.5f);
    const float mn = keep ? m : fmaxf(m, pmax), alpha = keep ? 1.0f : __builtin_amdgcn_exp2f((m - mn) * AT_C2), mnl = dead ? __builtin_inff() : mn * AT_C2; m = mn;
    float ps = 0.f;
#pragma unroll
    for (int r = 0; r < 16; ++r) { p0[r] = __builtin_amdgcn_exp2f(fmaf(p0[r], AT_C2, -mnl)); p1[r] = __builtin_amdgcn_exp2f(fmaf(p1[r], AT_C2, -mnl)); ps += p0[r] + p1[r]; }
    ps = xsum32(ps);
    l = l * alpha + ps;
    if (__any(alpha < 1.0f)) {
#pragma unroll
        for (int nb = 0; nb < 4; ++nb)
#pragma unroll
            for (int r = 0; r < 16; ++r) o[nb][r] *= alpha;
    }
    return alpha;
}
DI int at_crow(int r, int hi) { return (r & 3) + 8 * (r >> 2) + 4 * hi; }
constexpr int AT_STG = 0, STG_STR = 144, STG_WAVE = 32 * STG_STR;
DI void at_flush(bf16_t* orow0, LAS unsigned char* stg, const f32x16 (&o)[4], float scale, bool first, int lane) {
    const int r32 = lane & 31, hi = lane >> 5;
#pragma unroll
    for (int half = 0; half < 2; ++half) {
#pragma unroll
        for (int nn = 0; nn < 2; ++nn)
#pragma unroll
            for (int gq = 0; gq < 4; ++gq) { const int nb = 2 * half + nn;
                u32x2 v; v.x = cvt_pk_bf16(o[nb][4 * gq] * scale, o[nb][4 * gq + 1] * scale); v.y = cvt_pk_bf16(o[nb][4 * gq + 2] * scale, o[nb][4 * gq + 3] * scale);
                *(LAS u32x2*)(stg + r32 * STG_STR + (nn * 32 + 8 * gq + 4 * hi) * 2) = v; }
#pragma unroll
        for (int it = 0; it < 4; ++it) { const int row = it * 8 + (lane >> 3), ch = lane & 7;
            u32x4 s = *(const LAS u32x4*)(stg + row * STG_STR + ch * 16);
            bf16_t* gp = orow0 + (size_t)row * 2048 + half * 64 + ch * 8;
            if (!first) { const u32x4 t = *(const u32x4*)gp;
                s.x = cvt_pk_bf16(bflo(s.x) + bflo(t.x), bfhi(s.x) + bfhi(t.x)); s.y = cvt_pk_bf16(bflo(s.y) + bflo(t.y), bfhi(s.y) + bfhi(t.y));
                s.z = cvt_pk_bf16(bflo(s.z) + bflo(t.z), bfhi(s.z) + bfhi(t.z)); s.w = cvt_pk_bf16(bflo(s.w) + bflo(t.w), bfhi(s.w) + bfhi(t.w)); }
            *(u32x4*)gp = s; }
    }
}
DI void at_blocksums(const f32x16& p0, const f32x16& p1, int hi, float carry_in, float (&bs)[8], float& carry_out) {
    float lastv[8];
#pragma unroll
    for (int gq = 0; gq < 4; ++gq) {
        bs[gq] = (p0[4 * gq] + p0[4 * gq + 1]) + (p0[4 * gq + 2] + p0[4 * gq + 3]); lastv[gq] = p0[4 * gq + 3];
        bs[4 + gq] = (p1[4 * gq] + p1[4 * gq + 1]) + (p1[4 * gq + 2] + p1[4 * gq + 3]); lastv[4 + gq] = p1[4 * gq + 3];
    }
    float xs[8];
#pragma unroll
    for (int gi = 0; gi < 8; ++gi) xs[gi] = xget32(lastv[gi], hi);
#pragma unroll
    for (int gi = 0; gi < 8; ++gi) bs[gi] += hi ? xs[gi] : (gi > 0 ? xs[gi > 0 ? gi - 1 : 0] : carry_in);
    carry_out = xs[7];
}
DI void nsa_unit(const Params& P, const Frame& F, int b, int g, int tb) {
    unsigned char* ws = P.ws; LAS unsigned char* L = F.lds;
    int tid = threadIdx.x; asm volatile("" : "+v"(tid));
    const int lane = tid & 63, w = F.wave, r32 = lane & 31, hi = lane >> 5, hp = w >> 1;
    const int qi = (w & 1) * 32 + r32, q0 = tb * 64, pos = q0 + qi, tok = b * SEQ + pos, bg = b * 2 + g, head = g * 4 + hp;
    LAS float* imp = (LAS float*)(L + AT_IMP); LAS unsigned* selm = (LAS unsigned*)(L + AT_SELM);
    const float* gl = (const float*)(ws + WS_SMALL) + (size_t)tok * 64 + head * 3;
    const float g_cmp = fast_sigmoid(gl[0]), g_sel = fast_sigmoid(gl[1]), g_win = fast_sigmoid(gl[2]);
    bf16_t* const orow0 = (bf16_t*)(ws + WS_ONSA) + (size_t)(b * SEQ + q0 + (w & 1) * 32) * 2048 + head * 128;
    LAS unsigned char* const stg = L + AT_STG + w * STG_WAVE;
    bf16x8 qr[8];
    u32x4 rk[2], rv[2];
    f32x16 o[4], p0, p1;
    {
        const bf16_t* qp = (const bf16_t*)(ws + WS_QRAW) + (size_t)tok * 1024 + head * 128 + hi * 8;
#pragma unroll
        for (int ks = 0; ks < 8; ++ks) qr[ks] = *(const bf16x8*)(qp + ks * 16);
        const bf16_t* Kb = (const bf16_t*)(ws + WS_KCMP) + (size_t)bg * 128 * 128; const bf16_t* Vb = Kb + (size_t)16 * 128 * 128;
        int nmax = pos >= 31 ? ((pos - 31) >> 4) : -1;
#pragma unroll
        for (int nb = 0; nb < 4; ++nb)
#pragma unroll
            for (int r = 0; r < 16; ++r) o[nb][r] = 0.f;
        float m = -1e30f, l = 0.f;
        float bs0[8], bs1[8], carry0, carry1;
        if (tid < 64) selm[tid] = 0u;
        at_load(rk, rv, Kb, Vb, 0, tid);
        __syncthreads(); at_store(L, rk, rv, tid);
        at_load(rk, rv, Kb, Vb, 64, tid);
        __syncthreads(); at_store(L + AT_BUF, rk, rv, tid);
        at_qk(p0, p1, L, qr, r32, hi);
        asm volatile("" : "+v"(nmax));
#pragma unroll
        for (int r = 0; r < 16; ++r) { const int n = at_crow(r, hi); if (n > nmax) p0[r] = -__builtin_inff(); if (n + 32 > nmax) p1[r] = -__builtin_inff(); }
        at_softmax(p0, p1, m, l, o);
        at_pv(o, L, p0, p1, lane);
        at_blocksums(p0, p1, hi, 0.f, bs0, carry0);
        __syncthreads();
        at_qk(p0, p1, L + AT_BUF, qr, r32, hi);
        asm volatile("" : "+v"(nmax));
#pragma unroll
        for (int r = 0; r < 16; ++r) { const int n = 64 + at_crow(r, hi); if (n > nmax) p0[r] = -__builtin_inff(); if (n + 32 > nmax) p1[r] = -__builtin_inff(); }
        const float al1 = at_softmax(p0, p1, m, l, o);
        at_pv(o, L + AT_BUF, p0, p1, lane);
        at_blocksums(p0, p1, hi, carry0 * al1, bs1, carry1);
        const float inv = l > 0.f ? 1.0f / l : 0.f;
        __syncthreads();
        at_flush(orow0, stg, o, inv * g_cmp, true, lane);
        {
            const float f0 = al1 * inv, f1 = inv;
            int ib = (hp * 64 + qi) * 32 + hi; asm volatile("" : "+v"(ib));
#pragma unroll
            for (int gi = 0; gi < 8; ++gi) { imp[ib + 2 * gi] = bs0[gi] * f0; imp[ib + 16 + 2 * gi] = bs1[gi] * f1; }
        }
        __syncthreads();
        {
            LAS float* totl = (LAS float*)(L + AT_BUF + AT_V);
            int tid2 = threadIdx.x; asm volatile("" : "+v"(tid2));
#pragma unroll
            for (int q = 0; q < 4; ++q) { const int idx = tid2 + 512 * q, qq = idx >> 5, j = idx & 31;
                float sv = (imp[(0 * 64 + qq) * 32 + j] + imp[(1 * 64 + qq) * 32 + j]) + (imp[(2 * 64 + qq) * 32 + j] + imp[(3 * 64 + qq) * 32 + j]);
                sv += (j > tb) ? -1000.0f : ((j == 0 || j == tb || j == tb - 1) ? 1000.0f : 0.0f); totl[idx] = sv; }
            __syncthreads();
            const int qq = tid2 >> 3, sub = tid2 & 7; float v[32];
#pragma unroll
            for (int j = 0; j < 32; ++j) v[j] = totl[qq * 32 + j];
            unsigned bits = 0u;
#pragma unroll 1
            for (int jj = 0; jj < 4; ++jj) {
                const int j = sub * 4 + jj; const float vj = totl[qq * 32 + j];
                int rank = 0;
#pragma unroll
                for (int i = 0; i < 32; ++i) rank += (v[i] > vj || (v[i] == vj && i < j)) ? 1 : 0;
                if (rank < 16) bits |= 1u << j;
            }
            if (bits) __hip_atomic_fetch_or((LAS unsigned*)&selm[qq], bits, __ATOMIC_RELAXED, __HIP_MEMORY_SCOPE_WORKGROUP);
        }
        __syncthreads();
    }
    {
        const bf16_t* qp = (const bf16_t*)(ws + WS_QRAW) + (size_t)tok * 1024 + head * 128 + hi * 8;
        const f32x4* tp = (const f32x4*)((const f32x2*)(ws + WS_TAB) + (size_t)pos * 64 + hi * 8);
#pragma unroll
        for (int ks = 0; ks < 4; ++ks) {
            const u32x4 lo = *(const u32x4*)(qp + ks * 16), hh = *(const u32x4*)(qp + 64 + ks * 16);
            const f32x4 c01 = tp[ks * 8 + 0], c23 = tp[ks * 8 + 1], c45 = tp[ks * 8 + 2], c67 = tp[ks * 8 + 3];
            u32x4 ol, oh;
            { const float a0 = bflo(lo.x), a1 = bfhi(lo.x), b0 = bflo(hh.x), b1 = bfhi(hh.x); ol.x = cvt_pk_bf16(a0 * c01[0] - b0 * c01[1], a1 * c01[2] - b1 * c01[3]); oh.x = cvt_pk_bf16(b0 * c01[0] + a0 * c01[1], b1 * c01[2] + a1 * c01[3]); }
            { const float a0 = bflo(lo.y), a1 = bfhi(lo.y), b0 = bflo(hh.y), b1 = bfhi(hh.y); ol.y = cvt_pk_bf16(a0 * c23[0] - b0 * c23[1], a1 * c23[2] - b1 * c23[3]); oh.y = cvt_pk_bf16(b0 * c23[0] + a0 * c23[1], b1 * c23[2] + a1 * c23[3]); }
            { const float a0 = bflo(lo.z), a1 = bfhi(lo.z), b0 = bflo(hh.z), b1 = bfhi(hh.z); ol.z = cvt_pk_bf16(a0 * c45[0] - b0 * c45[1], a1 * c45[2] - b1 * c45[3]); oh.z = cvt_pk_bf16(b0 * c45[0] + a0 * c45[1], b1 * c45[2] + a1 * c45[3]); }
            { const float a0 = bflo(lo.w), a1 = bfhi(lo.w), b0 = bflo(hh.w), b1 = bfhi(hh.w); ol.w = cvt_pk_bf16(a0 * c67[0] - b0 * c67[1], a1 * c67[2] - b1 * c67[3]); oh.w = cvt_pk_bf16(b0 * c67[0] + a0 * c67[1], b1 * c67[2] + a1 * c67[3]); }
            qr[ks] = __builtin_bit_cast(bf16x8, ol); qr[ks + 4] = __builtin_bit_cast(bf16x8, oh);
        }
    }
    const unsigned mysel = selm[qi];
    unsigned uni = 0u;
    { unsigned u0 = selm[lane];
#pragma unroll
      for (int o_ = 32; o_ > 0; o_ >>= 1) u0 |= __shfl_xor(u0, o_);
      uni = __builtin_amdgcn_readfirstlane(u0); }
#pragma unroll 1
    for (int br = 0; br < 2; ++br) {
        const bf16_t* Kb = (const bf16_t*)(ws + WS_KV + (size_t)(br == 0 ? 2 : 4) * KV_STRIDE) + (size_t)bg * SEQ * 128;
        const bf16_t* Vb = (const bf16_t*)(ws + WS_KV + (size_t)(br == 0 ? 3 : 5) * KV_STRIDE) + (size_t)bg * SEQ * 128;
        unsigned tl = (br == 0) ? (uni & (tb == 31 ? 0xffffffffu : ((2u << tb) - 1u))) : ((tb == 31 ? 0xffffffffu : ((2u << tb) - 1u)) & ~(tb >= 9 ? ((1u << (tb - 8)) - 1u) : 0u));
#pragma unroll
        for (int nb = 0; nb < 4; ++nb)
#pragma unroll
            for (int r = 0; r < 16; ++r) o[nb][r] = 0.f;
        float m = -1e30f, l = 0.f;
        int j = __builtin_ctz(tl); tl &= tl - 1u;
        at_load(rk, rv, Kb, Vb, j * 64, tid);
        __syncthreads();
        at_store(L, rk, rv, tid);
        int jn = tl ? __builtin_ctz(tl) : -1; tl &= tl - 1u;
        if (jn >= 0) at_load(rk, rv, Kb, Vb, jn * 64, tid);
        int cur = 0;
        for (;;) {
            __syncthreads();
            const LAS unsigned char* Lb = L + cur * AT_BUF;
            if (jn >= 0) {
                at_store(L + (cur ^ 1) * AT_BUF, rk, rv, tid);
                const int jnn = tl ? __builtin_ctz(tl) : -1;
                if (jnn >= 0) at_load(rk, rv, Kb, Vb, jnn * 64, tid);
            }
            at_qk(p0, p1, Lb, qr, r32, hi);
            int qim = qi; asm volatile("" : "+v"(qim));
            bool dead = false;
            if (br == 0) {
                dead = !((mysel >> j) & 1u);
                if (j == tb) {
#pragma unroll
                    for (int r = 0; r < 16; ++r) { const int kr = at_crow(r, hi); if (kr > qim) p0[r] = -__builtin_inff(); if (kr + 32 > qim) p1[r] = -__builtin_inff(); }
                }
            } else {
                if (j == tb) {
#pragma unroll
                    for (int r = 0; r < 16; ++r) { const int kr = at_crow(r, hi); if (kr > qim) p0[r] = -__builtin_inff(); if (kr + 32 > qim) p1[r] = -__builtin_inff(); }
                } else if (j == tb - 8) {
#pragma unroll
                    for (int r = 0; r < 16; ++r) { const int kr = at_crow(r, hi); if (kr <= qim) p0[r] = -__builtin_inff(); if (kr + 32 <= qim) p1[r] = -__builtin_inff(); }
                }
            }
            at_softmax(p0, p1, m, l, o, dead);
            at_pv(o, Lb, p0, p1, lane);
            if (jn < 0) break;
            j = jn; jn = tl ? __builtin_ctz(tl) : -1; tl &= tl - 1u; cur ^= 1;
        }
        __syncthreads();
        at_flush(orow0, stg, o, (br == 0 ? g_sel : g_win) / l, false, lane);
    }
    __syncthreads();
}
DI void nsa_phase(const Params& P, const Frame& F) {
    for (int it = F.bid; it < 256; it += F.G) {
        const int bgi = it >> 4, pr = it & 15;
#pragma unroll 1
        for (int u = 0; u < 2; ++u) nsa_unit(P, F, bgi >> 1, bgi & 1, u ? pr : 31 - pr);
    }
}
__global__ void __launch_bounds__(512, 2) fwd(Params P) {
    extern __shared__ __attribute__((aligned(16))) unsigned char lds_raw[];
    Frame F; F.lds = (LAS unsigned char*)lds_raw; F.tid = threadIdx.x; F.lane = F.tid & 63; F.wave = __builtin_amdgcn_readfirstlane(F.tid >> 6); F.G = gridDim.x; F.bid = blockIdx.x;
    F.ctl = (unsigned*)(P.ws + WS_CTL);
    volatile LAS unsigned* misc = (volatile LAS unsigned*)(F.lds + LDS_MISC);
    if (F.tid < 64) misc[F.tid] = 0u;
    __syncthreads();
    XcdBarrier bar = xcd_barrier_post(F.ctl + CW_BAR, misc + 8);
    unsigned char* ws = P.ws;
#define FRESH(FN) Frame FN = F; { int t_ = threadIdx.x; asm volatile("" : "+v"(t_)); FN.tid = t_; FN.lane = t_ & 63; }
    LAS int* tb = (LAS int*)(F.lds + LDS_TAB);

    { FRESH(Fp); p0_prologue(P, Fp); }
    xcd_barrier(bar);
#ifdef SPLIT_CONV
    constexpr int CONV_PER64 = SPLIT_CONV, CONV_TAIL = SPLIT_TAIL;
    const bool split = (F.G & 63) == 0;
    if (split && (F.bid & 63) >= 64 - CONV_PER64) {
        FRESH(Fp); Fp.G = (F.G >> 6) * CONV_PER64; Fp.bid = (F.bid >> 6) * CONV_PER64 + ((F.bid & 63) - (64 - CONV_PER64));
        cvt8_range(P, Fp, 0, CVT8_DN - CONV_TAIL);
    } else
#endif
    {
#ifdef SPLIT_CONV
        const int Gg = split ? (F.G >> 6) * (64 - CONV_PER64) : F.G, cg = split ? (F.bid >> 6) * (64 - CONV_PER64) + (F.bid & 63) : F.bid;
#else
        const int Gg = F.G, cg = F.bid;
#endif
        SchedStd Sa{(const char*)(ws + WS_HN), (const char*)(ws + WS_WT1), 4096u, 4096u, 64, N1A_TILES, Gg, cg};
        Epi1<false> Ea{ws, P.in[I_BMG], F.lds};
        pg8::gemm_phase<false>(F.lds, 2048, 4096u, Sa, Ea);
        Epi1<true> Eb{ws, P.in[I_BMG], F.lds};
        if (split && Gg == 160) {
            SchedStdB Sb{(const char*)(ws + WS_HN8), (const char*)(ws + WS_WT1B), 2048u, 2048u, 64, N1B_TILES, Gg, cg};
            pg8::gemm_phase<true>(F.lds, 1024, 2048u, Sb, Eb);
        } else {
            SchedStd Sb{(const char*)(ws + WS_HN8), (const char*)(ws + WS_WT1B), 2048u, 2048u, 64, N1B_TILES, Gg, cg};
            pg8::gemm_phase<true>(F.lds, 1024, 2048u, Sb, Eb);
        }
#ifdef SPLIT_CONV
        if (split && Gg == 160) {
            constexpr int CONV_BIAS = 10;
            if (cg >= 32 && cg < 64) { FRESH(Fp); Fp.G = 32; Fp.bid = cg - 32; cvt8_range(P, Fp, CVT8_DN - CONV_TAIL, CVT8_DN - CONV_TAIL + 32 * CONV_BIAS); }
            { FRESH(Fp); Fp.G = Gg; Fp.bid = cg; cvt8_range(P, Fp, CVT8_DN - CONV_TAIL + 32 * CONV_BIAS, CVT8_DN); }
        } else { FRESH(Fp); if (split) { Fp.G = Gg; Fp.bid = cg; cvt8_range(P, Fp, CVT8_DN - CONV_TAIL, CVT8_DN); } else cvt8_range(P, Fp, 0, CVT8_DN); }
#endif
    }
    xcd_barrier(bar);
    {
        EpiCmp E{(bf16_t*)(ws + WS_CPART)};
        for (int base = 0; base < 256; base += F.G) { SchedCmp S{ws, F.G, base + F.bid}; pg8::gemm_phase<false>(F.lds, 256, 8192u, S, E); }
        { FRESH(Fp); gla_prep(P, Fp); }
    }
    xcd_barrier(bar);
    { FRESH(Fp); cmp_stage2(P, Fp); }
    { FRESH(Fp); gla_scan(P, Fp); }
    xcd_barrier(bar);
    { FRESH(Fp); nsa_phase(P, Fp); }
    { FRESH(Fp); gla_post(P, Fp); }
    xcd_barrier(bar);
    {
        SchedProj S{(const char*)(ws + WS_ONSA), (const char*)(ws + WS_WPN), F.G, F.bid};
        EpiProjF E{ws};
        pg8::gemm_phase<false>(F.lds, 1024, 4096u, S, E);
    }
    xcd_barrier(bar);
    {
        SchedStd S{(const char*)(ws + WS_MIXED), (const char*)(ws + WS_WOUT), 4096u, 4096u, 64, 8, F.G, F.bid};
        EpiOut E{P.in[I_X], (bf16_t*)(ws + WS_X2), (float*)(ws + WS_SSQP)};
        pg8::gemm_phase<false>(F.lds, 2048, 4096u, S, E);
    }
    xcd_barrier(bar);
    { FRESH(Fp); p7_router(P, Fp); }
    xcd_barrier(bar);
    { FRESH(Fp); moe_table(Fp); }
    {
        SchedGU S{(const char*)(ws + WS_HN2), (const char*)(ws + WS_WGU), (const int*)(ws + WS_STOK), tb, F.G, F.bid};
        EpiGU E{ws + WS_ACT, P.in[I_BGU], F.lds};
        pg8::gemm_phase<true>(F.lds, 1024, 2048u, S, E);
    }
    xcd_barrier(bar);
    {
        SchedDN S{(const char*)(ws + WS_ACT), (const char*)(ws + WS_WDN), tb, F.G, F.bid};
        EpiDN E{ws + WS_EO, P.in[I_BDN], F.lds};
        pg8::gemm_phase<true>(F.lds, 1024, 2048u, S, E);
    }
    xcd_barrier(bar);
    { FRESH(Fp); p10_final(P, Fp); }
}
extern "C" void kernel_launch(void* const* d_in, const int* in_sizes, int n_in, void* d_out, int out_size, void* d_ws, size_t ws_size, hipStream_t stream) {
    static int grid = 0;
    if (grid == 0) {
        if (n_in != 25 || out_size != NTOK * DM || ws_size < WS_END) { fprintf(stderr, "kernel_launch: unexpected shapes n_in %d out %d ws %zu\n", n_in, out_size, ws_size); grid = -1; return; }
        int dev = 0, cus = 0, per_cu = 0;
        if (hipGetDevice(&dev) != hipSuccess || hipDeviceGetAttribute(&cus, hipDeviceAttributeMultiprocessorCount, dev) != hipSuccess) { grid = -1; return; }
        if (hipFuncSetAttribute((const void*)fwd, hipFuncAttributeMaxDynamicSharedMemorySize, LDS_BYTES) != hipSuccess) { fprintf(stderr, "kernel_launch: hipFuncSetAttribute failed\n"); grid = -1; return; }
        if (hipOccupancyMaxActiveBlocksPerMultiprocessor(&per_cu, (const void*)fwd, 512, LDS_BYTES) != hipSuccess || per_cu < 1) { fprintf(stderr, "kernel_launch: occupancy query says %d\n", per_cu); }
        (void)hipGetLastError();
        grid = cus;
    }
    if (grid < 0) return;
    if (hipMemsetAsync((char*)d_ws + WS_CTL, 0, CTL_ZERO_BYTES, stream) != hipSuccess) return;
    Params p{};
    for (int i = 0; i < 25; ++i) p.in[i] = (const float*)d_in[i];
    p.out = (float*)d_out; p.ws = (unsigned char*)d_ws; p.rope_r = pow(10000.0, -1.0 / 64.0);
    hipLaunchKernelGGL(fwd, dim3(grid), dim3(512), LDS_BYTES, stream, p);
}
```

```cpp
#include <hip/hip_runtime.h>
#define SPLIT_CONV 24
#define SPLIT_TAIL 768
#include <cstdio>
#include <cstdint>
#include <cmath>

#define LAS __attribute__((address_space(3)))
#define GAS __attribute__((address_space(1)))
typedef unsigned short bf16_t;
typedef short bf16x8 __attribute__((ext_vector_type(8)));
typedef short s16x4 __attribute__((ext_vector_type(4)));
typedef float f32x2 __attribute__((ext_vector_type(2)));
typedef float f32x4 __attribute__((ext_vector_type(4)));
typedef float f32x16 __attribute__((ext_vector_type(16)));
typedef unsigned u32x2 __attribute__((ext_vector_type(2)));
typedef unsigned u32x4 __attribute__((ext_vector_type(4)));
#define DI __device__ __forceinline__
#define LDS_BARRIER() do { asm volatile("s_waitcnt lgkmcnt(0)" ::: "memory"); __builtin_amdgcn_s_barrier(); asm volatile("" ::: "memory"); } while (0)

constexpr int NB = 8, SEQ = 2048, DM = 2048, NTOK = NB * SEQ;
constexpr int NSA_H = 8, NSA_G = 2, HPG = 4, DH = 128;
constexpr int NCMP = 127, CMP_HID = 256;
constexpr int GLA_H = 4, GDK = 128, GDV = 256, GCH = 64, GNC = SEQ / GCH;
constexpr int NEXP = 32, FF = 2048, ECAP = NTOK;
constexpr int IN_W = 5672;
constexpr int OFF_QN = 0, OFF_KV = 1024, OFF_GN = 2560, OFF_QG = 2584, OFF_KG = 3096, OFF_VG = 3608, OFF_RG = 4632, OFF_AG = 5656;
constexpr int N1_TILES = 39, N1 = N1_TILES * 256, N1A_TILES = 23, N1B_TILES = 16;
constexpr float NORM_EPS = 1e-5f;

constexpr size_t MiB = 1u << 20;
constexpr size_t WS_CTL = 0, CTL_ZERO_BYTES = 1 * MiB;
constexpr size_t WS_TAB = 1 * MiB;
constexpr size_t WS_CBIAS = 2 * MiB;
constexpr size_t WS_WRT = 2 * MiB + 65536;
constexpr size_t WS_WT1 = 4 * MiB;
constexpr size_t WS_WPN = 44 * MiB;
constexpr size_t WS_WOUT = 52 * MiB, WS_WCK1 = 60 * MiB, WS_WCV1 = 62 * MiB;
constexpr size_t WS_HN = 64 * MiB;
constexpr size_t WS_QRAW = 128 * MiB;
constexpr size_t WS_KV = 192 * MiB, KV_STRIDE = 8 * MiB;
constexpr size_t WS_QG = 240 * MiB, WS_KG = 256 * MiB, WS_VG = 272 * MiB, WS_RG = 304 * MiB;
constexpr size_t WS_SMALL = 336 * MiB;
constexpr size_t WS_MG = 340 * MiB;
constexpr size_t WS_ONSA = 468 * MiB;
constexpr size_t WS_MIXED = 660 * MiB;
constexpr size_t WS_X2 = 724 * MiB;
constexpr size_t WS_HN2 = 852 * MiB;
constexpr size_t WS_CPART = 916 * MiB;
constexpr size_t WS_KCMP = 980 * MiB;
constexpr size_t WS_GQT = 982 * MiB, WS_GKS = 1014 * MiB;
constexpr size_t WS_GATT = 1030 * MiB;
constexpr size_t WS_GDEC = 1038 * MiB;
constexpr size_t WS_GO = 1040 * MiB;
constexpr size_t WS_STOK = 1104 * MiB;
constexpr size_t WS_TREC = 1106 * MiB;
constexpr size_t WS_ACT = 1112 * MiB;
constexpr size_t WS_EO = 1400 * MiB;
constexpr size_t WS_WGU = 1688 * MiB;
constexpr size_t WS_WDN = 2200 * MiB;
constexpr size_t WS_HN8 = 1944 * MiB;
constexpr size_t WS_WT1B = 1976 * MiB;
constexpr size_t WS_SSQP = 2064 * MiB;
constexpr size_t WS_END = 2456 * MiB;
constexpr int CW_BAR = 4096, CW_CNT = 8192;

constexpr int RING_BYTES = 131072;
constexpr int LDS_TAB = RING_BYTES;
constexpr int LDS_MISC = RING_BYTES + 8192;
constexpr int LDS_BYTES = 147456;

typedef __bf16 bf16x2_t __attribute__((ext_vector_type(2)));
DI unsigned cvt_pk_bf16(float lo, float hi) { const f32x2 v = {lo, hi}; return __builtin_bit_cast(unsigned, __builtin_convertvector(v, bf16x2_t)); }
DI float bf2f(bf16_t b) { return __uint_as_float(((unsigned)b) << 16); }
DI float bflo(unsigned w) { return __uint_as_float(w << 16); }
DI float bfhi(unsigned w) { return __uint_as_float(w & 0xffff0000u); }
DI bf16_t f2bf(float f) { return (bf16_t)(cvt_pk_bf16(f, 0.f) & 0xffffu); }
constexpr float W8_SCALE = 64.0f, W8_INV = 1.0f / 64.0f;
DI unsigned pk4_fp8(float a, float b, float c, float d) { int w = 0; w = __builtin_amdgcn_cvt_pk_fp8_f32(a, b, w, false); w = __builtin_amdgcn_cvt_pk_fp8_f32(c, d, w, true); return (unsigned)w; }
DI float wave_sum(float v) {
#pragma unroll
    for (int o = 32; o > 0; o >>= 1) v += __shfl_xor(v, o);
    return v;
}
DI float fast_sigmoid(float x) { return __builtin_amdgcn_rcpf(1.0f + __builtin_amdgcn_exp2f(-1.4426950408889634f * x)); }

#define XB_TMO      128
#define XB_XCNT(j)  (256  + 64 * (j))
#define XB_XSUB(j)  (1280 + 64 * (j))
#define XB_XGEN(j)  (2304 + 64 * (j))
#define XB_TOP      3328
#define XB_TOPGEN   3392
#define XCD_BAR_WORDS 3456
#define XB_SPIN_CAP (1u << 18)

__device__ __forceinline__ unsigned xb_ld(unsigned* p)              { return __hip_atomic_load(p, __ATOMIC_RELAXED, __HIP_MEMORY_SCOPE_AGENT); }
__device__ __forceinline__ unsigned xb_add(unsigned* p, unsigned v) { return __hip_atomic_fetch_add(p, v, __ATOMIC_RELAXED, __HIP_MEMORY_SCOPE_AGENT); }
__device__ __forceinline__ unsigned xb_xcc_id() { return (unsigned)__builtin_amdgcn_s_getreg((3 << 11) | 20) & 0xFu; }
#define XB_SPIN(cond, bar) do { unsigned _sp = 0; while (cond) { __builtin_amdgcn_s_sleep(1); \
    if ((++_sp & 255u) == 0u) { if (xb_ld(&(bar)[XB_TMO])) break; if (_sp > XB_SPIN_CAP) { atomicAdd(&(bar)[XB_TMO], 1u); break; } } } } while (0)

struct XcdBarrier { unsigned* bar; unsigned x; volatile LAS unsigned* st; };

__device__ __forceinline__ XcdBarrier xcd_barrier_post(unsigned* bar, volatile LAS unsigned* st) {
    XcdBarrier b; b.bar = bar; b.x = xb_xcc_id(); b.st = st;
    if (threadIdx.x == 0) (void)xb_add(&bar[XB_XCNT(b.x)], 1u);
    return b;
}
__device__ __forceinline__ void xcd_barrier_complete(unsigned* bar, unsigned x, unsigned& nloc, unsigned& nx) {
    const unsigned G = gridDim.x * gridDim.y * gridDim.z;
    unsigned sum, cnt, mine, sp = 0u;
    for (;;) {
        sum = 0u; cnt = 0u; mine = 0u;
#pragma unroll
        for (unsigned j = 0; j < 16; ++j) { const unsigned c = xb_ld(&bar[XB_XCNT(j)]); sum += c; cnt += (c > 0u) ? 1u : 0u; mine = (j == x) ? c : mine; }
        if (sum == G) break;
        __builtin_amdgcn_s_sleep(1);
        if ((++sp & 255u) == 0u) { if (xb_ld(&bar[XB_TMO])) break; if (sp > XB_SPIN_CAP) { atomicAdd(&bar[XB_TMO], 1u); break; } }
    }
    nloc = mine > 0u ? mine : 1u; nx = cnt > 0u ? cnt : 1u;
}
__device__ __forceinline__ void xcd_barrier(const XcdBarrier& b) {
    asm volatile("s_waitcnt vmcnt(0)" ::: "memory");
    __syncthreads();
    if (threadIdx.x == 0) {
        unsigned* bar = b.bar;
        __builtin_amdgcn_s_waitcnt(0);
        unsigned nloc = b.st[0], nx = b.st[1];
        if (nloc == 0u) { xcd_barrier_complete(bar, b.x, nloc, nx); b.st[0] = nloc; b.st[1] = nx; }
        const unsigned old = xb_add(&bar[XB_XSUB(b.x)], 1u);
        const unsigned gen = old / nloc;
        if (old + 1u == (gen + 1u) * nloc) {
            __builtin_amdgcn_fence(__ATOMIC_RELEASE, "agent");
            asm volatile("s_waitcnt vmcnt(0)" ::: "memory");
            const unsigned og = xb_add(&bar[XB_TOP], 1u);
            const unsigned tg = og / nx;
            if (og + 1u == (tg + 1u) * nx) xb_add(&bar[XB_TOPGEN], 1u);
            else XB_SPIN(xb_ld(&bar[XB_TOPGEN]) == tg, bar);
            __builtin_amdgcn_fence(__ATOMIC_ACQUIRE, "agent");
            xb_add(&bar[XB_XGEN(b.x)], 1u);
            asm volatile("s_waitcnt vmcnt(0)" ::: "memory");
        } else {
            XB_SPIN(xb_ld(&bar[XB_XGEN(b.x)]) == gen, bar);
            __builtin_amdgcn_fence(__ATOMIC_ACQUIRE, "agent");
            asm volatile("s_waitcnt vmcnt(0)" ::: "memory");
        }
    }
    __syncthreads();
}
namespace pg8 {
constexpr int BM = 256, BK = 64, HALF = 128, HTB = HALF * BK * 2, STAGE_BYTES = 8 * HTB, NXCD = 8, WGM = 8;
__host__ __device__ __forceinline__ int lds_byte(int r, int c) { const int st = (r >> 4) * 2 + (c >> 5), rr = r & 15, cc = c & 31, ob = rr * 64 + cc * 2; return st * 1024 + (ob ^ (((ob >> 9) & 1) << 5)); }
__host__ __device__ __forceinline__ void stage_rc(int b, int& R, int& C) { const int st = b / 1024, sb = b % 1024, swz = sb ^ (((sb >> 9) & 1) << 5); R = (st >> 1) * 16 + swz / 64; C = (st & 1) * 32 + (swz % 64) / 2; }
__host__ __device__ __forceinline__ int perm32(int rho) { const int n = rho >> 4, i = rho & 15; return 8 * (i >> 2) + 4 * n + (i & 3); }

struct Unit { const char* A; const char* B; int pm, pn, aux, rows, keep, par; };

DI bool static_tile(int i, int G, int c, int nM, int nN, int& pm, int& pn) {
    const int nwg = nM * nN; const long L = (long)i * G + c; if (L >= nwg) return false;
    int wgid = (int)L; { const int q = nwg / NXCD, r = nwg % NXCD, xcd = wgid % NXCD, off = wgid / NXCD; wgid = (xcd < r ? xcd * (q + 1) : r * (q + 1) + (xcd - r) * q) + off; }
    const int nig = WGM * nN, gid = wgid / nig, fm = gid * WGM, gsz = (nM - fm) < WGM ? (nM - fm) : WGM;
    pm = fm + ((wgid % nig) % gsz); pn = (wgid % nig) / gsz; return true;
}

DI bool static_tile_lin(long L, int nM, int nN, int& pm, int& pn) {
    const int nwg = nM * nN; if (L >= nwg) return false;
    int wgid = (int)L; { const int q = nwg / NXCD, r = nwg % NXCD, xcd = wgid % NXCD, off = wgid / NXCD; wgid = (xcd < r ? xcd * (q + 1) : r * (q + 1) + (xcd - r) * q) + off; }
    const int nig = WGM * nN, gid = wgid / nig, fm = gid * WGM, gsz = (nM - fm) < WGM ? (nM - fm) : WGM;
    pm = fm + ((wgid % nig) % gsz); pn = (wgid % nig) / gsz; return true;
}

constexpr int PRE_OFF = 131072 + 8192 + 1024;
template <class E> struct has_pre { template <class T> static constexpr bool f(decltype(T::PRE)*) { return T::PRE; } template <class T> static constexpr bool f(...) { return false; } static constexpr bool value = f<E>(nullptr); };
typedef int i32x8 __attribute__((ext_vector_type(8)));
template <bool FP8, class Epi, class Sched>
DI void gemm_phase(LAS unsigned char* lds, const int K, const unsigned ldb, const Sched& S, const Epi& E) {
    int tid = threadIdx.x; asm volatile("" : "+v"(tid));
    const int wid = __builtin_amdgcn_readfirstlane(tid >> 6), lane = tid & 63, wr = wid >> 2, wc = wid & 3, fr = lane & 15, fq = lane >> 4;
    const int nt = K / BK;
    int R[2], C[2]; unsigned voffB[2];
#pragma unroll
    for (int i = 0; i < 2; ++i) { stage_rc(tid * 16 + i * 8192, R[i], C[i]); const int Rb = (R[i] & ~31) + perm32(R[i] & 31); voffB[i] = (unsigned)Rb * ldb + (unsigned)C[i] * 2u; }
    const size_t kstep = (size_t)(BK * 2);
    const size_t hstepB = (size_t)HALF * ldb;
    const unsigned ldsw = (unsigned)wid * 1024u;
    const int aoff = lds_byte(wr * 64 + fr, fq * 8), boff = lds_byte(wc * 32 + fr, fq * 8);
#define PG8_SA(b, h) (((b) * 2 + (h)) * HTB)
#define PG8_SB(b, h) ((4 + (b) * 2 + (h)) * HTB)
#define PG8_STAGE_B(bufoff, gbase) do { _Pragma("unroll") for (int _i = 0; _i < 2; ++_i) \
        __builtin_amdgcn_global_load_lds((const unsigned*)((const char*)(gbase) + voffB[_i]), (LAS unsigned*)(lds + (bufoff) + ldsw + _i * 8192), 16, 0, 0); } while (0)
#define PG8_STAGE_A(bufoff, gbase, v, h) do { _Pragma("unroll") for (int _i = 0; _i < 2; ++_i) \
        __builtin_amdgcn_global_load_lds((const unsigned*)((const char*)(gbase) + (v)[(h) * 2 + _i]), (LAS unsigned*)(lds + (bufoff) + ldsw + _i * 8192), 16, 0, 0); } while (0)
#define PG8_LDA(dst, b, h) do { _Pragma("unroll") for (int m = 0; m < 4; ++m) _Pragma("unroll") for (int k = 0; k < 2; ++k) dst[m][k] = *(const LAS bf16x8*)(lds + PG8_SA(b, h) + aoff + m * 2048 + k * 1024); } while (0)
#define PG8_LDB(dst, b, h) do { _Pragma("unroll") for (int n = 0; n < 2; ++n) _Pragma("unroll") for (int k = 0; k < 2; ++k) dst[n][k] = *(const LAS bf16x8*)(lds + PG8_SB(b, h) + boff + n * 2048 + k * 1024); } while (0)
#define PG8_CAT(x) __builtin_bit_cast(i32x8, __builtin_shufflevector((x)[0], (x)[1], 0, 1, 2, 3, 4, 5, 6, 7, 8, 9, 10, 11, 12, 13, 14, 15))
#define PG8_MMA(ai, bj, At, Bt) do { __builtin_amdgcn_s_setprio(1); \
        if constexpr (FP8) { const i32x8 a0_ = PG8_CAT(At[0]), a1_ = PG8_CAT(At[1]), a2_ = PG8_CAT(At[2]), a3_ = PG8_CAT(At[3]), b0_ = PG8_CAT(Bt[0]), b1_ = PG8_CAT(Bt[1]); \
            asm volatile("s_nop 1\n\tv_mfma_f32_16x16x128_f8f6f4 %0, %8, %10, %0\n\tv_mfma_f32_16x16x128_f8f6f4 %1, %9, %10, %1\n\tv_mfma_f32_16x16x128_f8f6f4 %2, %8, %11, %2\n\tv_mfma_f32_16x16x128_f8f6f4 %3, %9, %11, %3\n\t" \
                         "v_mfma_f32_16x16x128_f8f6f4 %4, %8, %12, %4\n\tv_mfma_f32_16x16x128_f8f6f4 %5, %9, %12, %5\n\tv_mfma_f32_16x16x128_f8f6f4 %6, %8, %13, %6\n\tv_mfma_f32_16x16x128_f8f6f4 %7, %9, %13, %7" \
                : "+v"(acc[ai][bj][0][0]), "+v"(acc[ai][bj][0][1]), "+v"(acc[ai][bj][1][0]), "+v"(acc[ai][bj][1][1]), "+v"(acc[ai][bj][2][0]), "+v"(acc[ai][bj][2][1]), "+v"(acc[ai][bj][3][0]), "+v"(acc[ai][bj][3][1]) \
                : "v"(b0_), "v"(b1_), "v"(a0_), "v"(a1_), "v"(a2_), "v"(a3_)); } \
        else { _Pragma("unroll") for (int m = 0; m < 4; ++m) _Pragma("unroll") for (int n = 0; n < 2; ++n) _Pragma("unroll") for (int k = 0; k < 2; ++k) \
            acc[ai][bj][m][n] = __builtin_amdgcn_mfma_f32_16x16x32_bf16(Bt[n][k], At[m][k], acc[ai][bj][m][n], 0, 0, 0); } \
        __builtin_amdgcn_s_setprio(0); } while (0)
#define PG8_WAIT_V(n) asm volatile("s_waitcnt vmcnt(" #n ")" ::: "memory")
#define PG8_WAIT_L(n) asm volatile("s_waitcnt lgkmcnt(" #n ")" ::: "memory")
#define PG8_BAR __builtin_amdgcn_s_barrier()
#define PG8_SCHED __builtin_amdgcn_sched_barrier(0)
    Unit cur, nxt; int ui = 0;
    if (!S.next(0, cur)) return;
    f32x4 acc[2][2][4][2];
#pragma unroll
    for (int a = 0; a < 2; ++a)
#pragma unroll
        for (int b = 0; b < 2; ++b)
#pragma unroll
            for (int m = 0; m < 4; ++m)
#pragma unroll
                for (int n = 0; n < 2; ++n) acc[a][b][m][n] = (f32x4){0.f, 0.f, 0.f, 0.f};
    bf16x8 At[4][2], B0[2][2], B1[2][2];
    unsigned vAc[4], vAn[4];
    S.a_off(cur, R, C, vAc);
    const char* cA = cur.A; const char* cB = cur.B;
    PG8_STAGE_B(PG8_SB(0, 0), cB); PG8_STAGE_B(PG8_SB(0, 1), cB + hstepB); PG8_STAGE_A(PG8_SA(0, 0), cA, vAc, 0); PG8_STAGE_A(PG8_SA(0, 1), cA, vAc, 1);
    if (wr == 1) PG8_BAR;
    PG8_WAIT_V(2); PG8_BAR;
    PG8_STAGE_B(PG8_SB(1, 0), cB + kstep); PG8_STAGE_A(PG8_SA(1, 0), cA + kstep, vAc, 0); PG8_STAGE_B(PG8_SB(1, 1), cB + hstepB + kstep);
    PG8_WAIT_V(6); PG8_BAR;
    for (;;) {
        const bool has_next = S.next(ui + 1, nxt);
        const char* nA = has_next ? nxt.A : cA; const char* nB = has_next ? nxt.B : cB;
#pragma unroll
        for (int q = 0; q < 4; ++q) vAn[q] = vAc[q];
        cur.par = ui & 1;
        if constexpr (has_pre<Epi>::value) { if (wid == 0) E.pre(cur, lds + PRE_OFF + 1024 * (ui & 1)); }
        for (int t = 0; t < nt; t += 2) {
            const bool last = (t == nt - 2);
            if (Sched::A_PER_UNIT) { if (has_next && t == (nt >= 4 ? nt - 4 : nt - 2)) S.a_off(nxt, R, C, vAn); }
            const char* a1 = cA + (size_t)(t + 1) * kstep;
            const char* a2 = last ? nA : cA + (size_t)(t + 2) * kstep; const char* b2 = last ? nB : cB + (size_t)(t + 2) * kstep;
            const char* a3 = a2 + kstep; const char* b3 = b2 + kstep;
            unsigned v2[4];
#pragma unroll
            for (int q = 0; q < 4; ++q) v2[q] = (Sched::A_PER_UNIT && last) ? vAn[q] : vAc[q];
            PG8_LDB(B0, 0, 0); PG8_LDB(B1, 0, 1); PG8_SCHED; PG8_LDA(At, 0, 0); PG8_STAGE_A(PG8_SA(1, 1), a1, vAc, 1);
            PG8_WAIT_V(8); PG8_WAIT_L(0); PG8_BAR; PG8_MMA(0, 0, At, B0); PG8_MMA(0, 1, At, B1); PG8_BAR; PG8_SCHED;
            PG8_LDA(At, 0, 1); PG8_STAGE_B(PG8_SB(0, 0), b2); PG8_STAGE_B(PG8_SB(0, 1), b2 + hstepB); PG8_STAGE_A(PG8_SA(0, 0), a2, v2, 0);
            PG8_WAIT_V(8); PG8_WAIT_L(0); PG8_BAR; PG8_MMA(1, 0, At, B0); PG8_MMA(1, 1, At, B1); PG8_BAR; PG8_SCHED;
            PG8_LDB(B0, 1, 0); PG8_LDB(B1, 1, 1); PG8_SCHED; PG8_LDA(At, 1, 0); PG8_STAGE_A(PG8_SA(0, 1), a2, v2, 1);
            PG8_WAIT_V(8); PG8_WAIT_L(0); PG8_BAR; PG8_MMA(0, 0, At, B0); PG8_MMA(0, 1, At, B1); PG8_BAR; PG8_SCHED;
            PG8_LDA(At, 1, 1); PG8_STAGE_B(PG8_SB(1, 0), b3); PG8_STAGE_B(PG8_SB(1, 1), b3 + hstepB); PG8_STAGE_A(PG8_SA(1, 0), a3, v2, 0);
            PG8_WAIT_V(8); PG8_WAIT_L(0); PG8_BAR; PG8_MMA(1, 0, At, B0); PG8_MMA(1, 1, At, B1); PG8_BAR; PG8_SCHED;
        }
        if (wr == 0) PG8_BAR;
        if constexpr (FP8) asm volatile("s_nop 15\n\ts_nop 15" ::: "memory");
        E(acc, cur, wr, wc, fr, fq);
        if (!has_next) break;
        if (!cur.keep)
#pragma unroll
        for (int a = 0; a < 2; ++a)
#pragma unroll
            for (int b = 0; b < 2; ++b)
#pragma unroll
                for (int m = 0; m < 4; ++m)
#pragma unroll
                    for (int n = 0; n < 2; ++n) acc[a][b][m][n] = (f32x4){0.f, 0.f, 0.f, 0.f};
        cur = nxt; cA = nA; cB = nB; ++ui;
#pragma unroll
        for (int q = 0; q < 4; ++q) vAc[q] = vAn[q];
        if (wr == 1) PG8_BAR;
    }
    PG8_WAIT_V(0);
    PG8_BAR;
#undef PG8_SA
#undef PG8_SB
#undef PG8_STAGE_A
#undef PG8_STAGE_B
#undef PG8_LDA
#undef PG8_LDB
#undef PG8_MMA
#undef PG8_CAT
#undef PG8_WAIT_V
#undef PG8_WAIT_L
#undef PG8_BAR
#undef PG8_SCHED
}
}
struct Params { const float* in[25]; float* out; unsigned char* ws; double rope_r; };
enum { I_X = 0, I_NORM_MIX, I_W_IN, I_CPOS_K, I_CPOS_V, I_WCK1, I_WCK2, I_WCV1, I_WCV2, I_WGA, I_BGA, I_GLA_NORM, I_WPN, I_WPG, I_WMG, I_BMG, I_WOUT, I_NORM_MOE, I_WR, I_BR, I_WGU, I_BGU, I_WDN, I_BDN, I_NORM_FINAL };

struct Frame { LAS unsigned char* lds; int tid, lane, wave, G, bid; unsigned* ctl; };

constexpr int CVT_J0 = 0, CVT_J2 = CVT_J0 + 92 * 16, CVT_J3 = CVT_J2 + 256, CVT_J4 = CVT_J3 + 256, CVT_J5 = CVT_J4 + 512, CVT_J6 = CVT_J5 + 128, CVT_END = CVT_J6 + 128;
constexpr int CVT8_GU = 32 * 512, CVT8_DN = CVT8_GU + 32 * 256;
constexpr int CVT8_W1I = CVT8_DN + 0, CVT8_END = CVT8_W1I + 64 * 8;
DI int map_in1(int j) {
    const int t = j >> 8, p = j & 255;
    if (t < 10) { const int bj = p >> 7, x = p & 127, hd = x >> 6, d = (x & 63) + 64 * bj; return (t < 4) ? (2 * t + hd) * 128 + d : OFF_KV + (t - 4) * 256 + hd * 128 + d; }
    if (t < 22) return OFF_QG + (t - 10) * 256 + p;
    return p < 24 ? OFF_GN + p : (p < 40 ? OFF_AG + (p - 24) : -1);
}
DI int tileA_old(int ta) { return ta; }
DI int tileB_old(int tb) { return 23 + tb; }
DI int map_gu(int j) { const int pn = j >> 8, p = j & 255, bj = p >> 7, x = p & 127; return bj * FF + pn * 128 + x; }
struct CvtDesc { const float* src; bf16_t* dst; int ld, K, j0, k0, col, dK; };
DI void cvt_decode(const Params& P, int tid, int g, CvtDesc& d) {
    const float* src; bf16_t* dst; int ld, K, loc, kind = 0, nrt = 32, dK = 0;
    unsigned char* ws = P.ws;
    if (g < CVT_J2)      { nrt = 92; loc = g - CVT_J0; src = P.in[I_W_IN]; ld = IN_W; K = 2048; dst = (bf16_t*)(ws + WS_WT1); kind = 1; }
    else if (g < CVT_J3) { loc = g - CVT_J2; src = P.in[I_WPN]; ld = 2048; K = 1024; dst = (bf16_t*)(ws + WS_WPN); dK = 2048; }
    else if (g < CVT_J4) { loc = g - CVT_J3; src = P.in[I_WPG]; ld = 2048; K = 1024; dst = (bf16_t*)(ws + WS_WPN) + 1024; dK = 2048; }
    else if (g < CVT_J5) { loc = g - CVT_J4; src = P.in[I_WOUT]; ld = 2048; K = 2048; dst = (bf16_t*)(ws + WS_WOUT); }
    else if (g < CVT_J6) { nrt = 4; loc = g - CVT_J5; src = P.in[I_WCK1]; ld = 256; K = 4096; dst = (bf16_t*)(ws + WS_WCK1); }
    else                 { nrt = 4; loc = g - CVT_J6; src = P.in[I_WCV1]; ld = 256; K = 4096; dst = (bf16_t*)(ws + WS_WCV1); }
    d.dK = dK ? dK : K;
    d.src = src; d.dst = dst; d.ld = ld; d.K = K; d.j0 = (loc % nrt) * 64; d.k0 = (loc / nrt) * 128;
    const int jj = d.j0 + 4 * (tid & 15);
    d.col = kind == 1 ? map_in1(tileA_old(jj >> 8) * 256 + (jj & 255)) : (kind == 2 ? map_gu(jj) : jj);
}
DI void cvt_load(const CvtDesc& d, int tid, f32x4 (&v)[4]) {
    const int kp = tid >> 4;
#pragma unroll
    for (int it = 0; it < 2; ++it) {
        const int k = d.k0 + 2 * kp + 64 * it;
        if (d.col >= 0) { v[2 * it] = __builtin_nontemporal_load((const f32x4*)(d.src + (size_t)k * d.ld + d.col)); v[2 * it + 1] = __builtin_nontemporal_load((const f32x4*)(d.src + (size_t)(k + 1) * d.ld + d.col)); }
        else { v[2 * it] = (f32x4){0.f, 0.f, 0.f, 0.f}; v[2 * it + 1] = v[2 * it]; }
    }
}
DI void cvt_finish(const CvtDesc& d, LAS unsigned* T, int tid, const f32x4 (&v)[4]) {
    const int jq = tid & 15, kp = tid >> 4;
#pragma unroll
    for (int it = 0; it < 2; ++it)
#pragma unroll
        for (int c = 0; c < 4; ++c) T[(4 * jq + c) * 65 + kp + 32 * it] = cvt_pk_bf16(v[2 * it][c], v[2 * it + 1][c]);
    LDS_BARRIER();
#pragma unroll
    for (int i = 0; i < 2; ++i) {
        const int p = tid + 512 * i, j = p >> 4, c = p & 15;
        u32x4 o; o.x = T[j * 65 + 4 * c + 0]; o.y = T[j * 65 + 4 * c + 1]; o.z = T[j * 65 + 4 * c + 2]; o.w = T[j * 65 + 4 * c + 3];
        *(u32x4*)(d.dst + (size_t)(d.j0 + j) * d.dK + d.k0 + 8 * c) = o;
    }
}
DI void cvt_all(const Params& P, const Frame& F) {
    const int tid = F.tid, G = F.G;
    CvtDesc d0, d1, d2; f32x4 va[4], vb[4], vc[4];
    int g = F.bid;
    if (g >= CVT_END) return;
    cvt_decode(P, tid, g, d0); cvt_load(d0, tid, va);
    if (g + G < CVT_END) { cvt_decode(P, tid, g + G, d1); cvt_load(d1, tid, vb); }
    int par = 0;
    for (; g < CVT_END; g += G) {
        if (g + 2 * G < CVT_END) { cvt_decode(P, tid, g + 2 * G, d2); cvt_load(d2, tid, vc); }
        cvt_finish(d0, (LAS unsigned*)(F.lds + par * 16640), tid, va);
        par ^= 1;
        d0 = d1; d1 = d2;
#pragma unroll
        for (int i = 0; i < 4; ++i) { va[i] = vb[i]; vb[i] = vc[i]; }
    }
    __syncthreads();
}

struct Cvt8Desc { const float* src; unsigned char* dst; int ld, Kb, j0, k0, col; };
DI void cvt8_decode(const Params& P, int tid, int g, Cvt8Desc& d) {
    unsigned char* ws = P.ws; int loc, nrt, kind;
    d.Kb = 2048;
    if (g < CVT8_GU) { const int e = g >> 9; loc = g & 511; nrt = 64; kind = 2; d.src = P.in[I_WGU] + (size_t)e * 2048 * 4096; d.ld = 4096; d.dst = ws + WS_WGU + (size_t)e * 4096 * 2048; }
    else if (g < CVT8_DN) { const int gg = g - CVT8_GU, e = gg >> 8; loc = gg & 255; nrt = 32; kind = 0; d.src = P.in[I_WDN] + (size_t)e * 2048 * 2048; d.ld = 2048; d.dst = ws + WS_WDN + (size_t)e * 2048 * 2048; }
    else if (g < CVT8_W1I) { loc = g - CVT8_DN; nrt = 28; kind = 3; d.src = P.in[I_W_IN]; d.ld = IN_W; d.dst = ws + WS_WT1B; }
    else { loc = g - CVT8_W1I; nrt = 64; kind = 0; d.src = P.in[I_WMG]; d.ld = 4096; d.dst = ws + WS_WT1B; }
    d.j0 = (loc % nrt) * 64; d.k0 = (loc / nrt) * 256;
    const int jj = d.j0 + 4 * (tid & 15);
    d.col = kind == 2 ? map_gu(jj) : (kind == 3 ? map_in1(tileB_old(jj >> 8) * 256 + (jj & 255)) : jj);
}
DI void cvt8_load(const Cvt8Desc& d, int tid, f32x4 (&v)[8]) {
    const float* p = d.src + (size_t)(d.k0 + 8 * (tid >> 4)) * d.ld + d.col;
#pragma unroll
    for (int r = 0; r < 8; ++r) v[r] = __builtin_nontemporal_load((const f32x4*)(p + (size_t)r * d.ld));
}
DI void cvt8_finish(const Cvt8Desc& d, LAS unsigned* T, int tid, const f32x4 (&v)[8]) {
    const int jq = tid & 15, kg = tid >> 4;
#pragma unroll
    for (int c = 0; c < 4; ++c) {
        T[(4 * jq + c) * 65 + 2 * kg] = pk4_fp8(v[0][c] * W8_SCALE, v[1][c] * W8_SCALE, v[2][c] * W8_SCALE, v[3][c] * W8_SCALE);
        T[(4 * jq + c) * 65 + 2 * kg + 1] = pk4_fp8(v[4][c] * W8_SCALE, v[5][c] * W8_SCALE, v[6][c] * W8_SCALE, v[7][c] * W8_SCALE);
    }
    LDS_BARRIER();
#pragma unroll
    for (int i = 0; i < 2; ++i) {
        const int p = tid + 512 * i, j = p >> 4, c = p & 15;
        u32x4 o; o.x = T[j * 65 + 4 * c + 0]; o.y = T[j * 65 + 4 * c + 1]; o.z = T[j * 65 + 4 * c + 2]; o.w = T[j * 65 + 4 * c + 3];
        __builtin_nontemporal_store(o, (u32x4*)(d.dst + (size_t)(d.j0 + j) * d.Kb + d.k0 + 16 * c));
    }
}
DI void cvt8_issue(const Params& P, int tid, int g, int gend, f32x4 (&v)[8]) { if (g < gend) { Cvt8Desc d; cvt8_decode(P, tid, g, d); cvt8_load(d, tid, v); } }
DI void cvt8_done(const Params& P, const Frame& F, int g, int gend, int& par, const f32x4 (&v)[8]) {
    if (g < gend) { Cvt8Desc d; cvt8_decode(P, F.tid, g, d); cvt8_finish(d, (LAS unsigned*)(F.lds + par * 16640), F.tid, v); par ^= 1; } }
DI void cvt8_range(const Params& P, const Frame& F, int gbeg, int gend) {
    const int tid = F.tid, G = F.G;
    f32x4 va[8], vb[8], vc[8];
    int g = gbeg + F.bid, par = 0;
    cvt8_issue(P, tid, g, gend, va); cvt8_issue(P, tid, g + G, gend, vb);
    for (; g < gend; g += 3 * G) {
        cvt8_issue(P, tid, g + 2 * G, gend, vc); cvt8_done(P, F, g, gend, par, va);
        cvt8_issue(P, tid, g + 3 * G, gend, va); cvt8_done(P, F, g + G, gend, par, vb);
        cvt8_issue(P, tid, g + 4 * G, gend, vb); cvt8_done(P, F, g + 2 * G, gend, par, vc);
    }
    __syncthreads();
}

DI void rms_row_bf16(const float* x, const float* gain, bf16_t* out, unsigned char* out8, int lane) {
    f32x4 v[8]; float ss = 0.f;
#pragma unroll
    for (int i = 0; i < 8; ++i) { v[i] = *(const f32x4*)(x + (i * 64 + lane) * 4); ss += v[i][0] * v[i][0] + v[i][1] * v[i][1] + v[i][2] * v[i][2] + v[i][3] * v[i][3]; }
    ss = wave_sum(ss);
    const float rs = __builtin_amdgcn_rsqf(ss * (1.0f / 2048.0f) + NORM_EPS);
#pragma unroll
    for (int i = 0; i < 8; ++i) { const f32x4 g = *(const f32x4*)(gain + (i * 64 + lane) * 4);
        u32x2 w; w.x = cvt_pk_bf16(v[i][0] * rs * g[0], v[i][1] * rs * g[1]); w.y = cvt_pk_bf16(v[i][2] * rs * g[2], v[i][3] * rs * g[3]);
        *(u32x2*)(out + (i * 64 + lane) * 4) = w;
        *(unsigned*)(out8 + (i * 64 + lane) * 4) = pk4_fp8(v[i][0] * rs * g[0], v[i][1] * rs * g[1], v[i][2] * rs * g[2], v[i][3] * rs * g[3]); }
}

DI void rms_rows2(const float* x0, const float* x1, bool two, const float* gain, bf16_t* o0, bf16_t* o1, unsigned char* p0, unsigned char* p1, int lane) {
    f32x4 v[2][8]; float ss0 = 0.f, ss1 = 0.f;
#pragma unroll
    for (int i = 0; i < 8; ++i) { v[0][i] = __builtin_nontemporal_load((const f32x4*)(x0 + (i * 64 + lane) * 4)); v[1][i] = __builtin_nontemporal_load((const f32x4*)(x1 + (i * 64 + lane) * 4)); }
#pragma unroll
    for (int i = 0; i < 8; ++i) { ss0 += v[0][i][0] * v[0][i][0] + v[0][i][1] * v[0][i][1] + v[0][i][2] * v[0][i][2] + v[0][i][3] * v[0][i][3];
                                  ss1 += v[1][i][0] * v[1][i][0] + v[1][i][1] * v[1][i][1] + v[1][i][2] * v[1][i][2] + v[1][i][3] * v[1][i][3]; }
    ss0 = wave_sum(ss0); ss1 = wave_sum(ss1);
    const float rs0 = __builtin_amdgcn_rsqf(ss0 * (1.0f / 2048.0f) + NORM_EPS), rs1 = __builtin_amdgcn_rsqf(ss1 * (1.0f / 2048.0f) + NORM_EPS);
#pragma unroll
    for (int i = 0; i < 8; ++i) { const f32x4 g = *(const f32x4*)(gain + (i * 64 + lane) * 4);
        { const f32x4 y = v[0][i] * rs0 * g; u32x2 w; w.x = cvt_pk_bf16(y[0], y[1]); w.y = cvt_pk_bf16(y[2], y[3]); *(u32x2*)(o0 + (i * 64 + lane) * 4) = w; *(unsigned*)(p0 + (i * 64 + lane) * 4) = pk4_fp8(y[0], y[1], y[2], y[3]); }
        if (two) { const f32x4 y = v[1][i] * rs1 * g; u32x2 w; w.x = cvt_pk_bf16(y[0], y[1]); w.y = cvt_pk_bf16(y[2], y[3]); *(u32x2*)(o1 + (i * 64 + lane) * 4) = w; *(unsigned*)(p1 + (i * 64 + lane) * 4) = pk4_fp8(y[0], y[1], y[2], y[3]); } }
}

DI void p0_prologue(const Params& P, const Frame& F) {
    unsigned char* ws = P.ws;
    { const int stride = F.G * 8;
      for (int row = F.bid * 8 + F.wave; row < NTOK; row += 2 * stride) { const bool two = row + stride < NTOK; const int r1 = two ? row + stride : row;
          rms_rows2(P.in[I_X] + (size_t)row * DM, P.in[I_X] + (size_t)r1 * DM, two, P.in[I_NORM_MIX], (bf16_t*)(ws + WS_HN) + (size_t)row * DM, (bf16_t*)(ws + WS_HN) + (size_t)r1 * DM,
                    ws + WS_HN8 + (size_t)row * DM, ws + WS_HN8 + (size_t)r1 * DM, F.lane); } }
    for (int idx = F.bid * 512 + F.tid; idx < SEQ * 64; idx += F.G * 512) {
        const int s = idx >> 6, i = idx & 63;
        double f = 1.0, r = P.rope_r; int e = i;
        while (e) { if (e & 1) f *= r; r *= r; e >>= 1; }
        const double a = (double)s * (double)(float)f * 0.15915494309189535;
        const float fr = (float)(a - __builtin_rint(a));
        f32x2 cs; cs.x = __builtin_amdgcn_cosf(fr); cs.y = __builtin_amdgcn_sinf(fr);
        *(f32x2*)(ws + WS_TAB + (size_t)idx * 8) = cs;
    }
    for (int idx = F.bid * 512 + F.tid; idx < NEXP * DM; idx += F.G * 512) {
        const int e = idx >> 11, k = idx & 2047;
        const float w = P.in[I_WR][k * NEXP + e] * P.in[I_NORM_MOE][k];
        const bf16_t hi = f2bf(w); const bf16_t lo = f2bf(w - bf2f(hi));
        ((bf16_t*)(ws + WS_WRT))[idx] = hi; ((bf16_t*)(ws + WS_WRT))[NEXP * DM + idx] = lo;
    }
    if (F.bid >= F.G - 32) {
        const int chunk = F.bid - (F.G - 32), kv = F.tid >> 8, c = F.tid & 255;
        const float* pos = P.in[kv ? I_CPOS_V : I_CPOS_K] + chunk * 128; const float* w1 = P.in[kv ? I_WCV1 : I_WCK1] + (size_t)chunk * 128 * 256 + c;
        float a0 = 0.f, a1 = 0.f, a2 = 0.f, a3 = 0.f;
#pragma unroll 8
        for (int k = 0; k < 128; k += 4) { a0 += pos[k] * w1[(size_t)k * 256]; a1 += pos[k + 1] * w1[(size_t)(k + 1) * 256]; a2 += pos[k + 2] * w1[(size_t)(k + 2) * 256]; a3 += pos[k + 3] * w1[(size_t)(k + 3) * 256]; }
        ((float*)(ws + WS_CBIAS))[chunk * 512 + F.tid] = (a0 + a1) + (a2 + a3);
    }
    cvt_all(P, F);
    cvt8_range(P, F, CVT8_DN, CVT8_END);
#ifndef SPLIT_CONV
    cvt8_range(P, F, 0, CVT8_DN);
#endif
}
using pg8::Unit;
typedef f32x4 Acc[2][2][4][2];
DI void st8(bf16_t* p, const f32x4 a, const f32x4 b) { u32x4 w; w.x = cvt_pk_bf16(a[0], a[1]); w.y = cvt_pk_bf16(a[2], a[3]); w.z = cvt_pk_bf16(b[0], b[1]); w.w = cvt_pk_bf16(b[2], b[3]); *(u32x4*)p = w; }

struct SchedStd {
    static constexpr bool A_PER_UNIT = false;
    const char* A; const char* B; unsigned lda, ldb; int nM, nN, G, c;
    DI bool next(int i, Unit& u) const { int pm, pn; if (!pg8::static_tile(i, G, c, nM, nN, pm, pn)) return false;
        u.A = A + (size_t)pm * 256 * lda; u.B = B + (size_t)pn * 256 * ldb; u.pm = pm; u.pn = pn; u.aux = 0; u.rows = 256; u.keep = 0; return true; }
    DI void a_off(const Unit&, const int (&R)[2], const int (&C)[2], unsigned (&v)[4]) const {
#pragma unroll
        for (int h = 0; h < 2; ++h)
#pragma unroll
            for (int i = 0; i < 2; ++i) v[h * 2 + i] = (unsigned)(h * 128 + R[i]) * lda + (unsigned)C[i] * 2u; }
};

struct SchedStdB {
    static constexpr bool A_PER_UNIT = false;
    const char* A; const char* B; unsigned lda, ldb; int nM, nN, G, c;
    DI bool next(int i, Unit& u) const { int pm, pn; long L;
        if (i < 5) L = (long)i * 160 + c; else if (i == 5) { if (c < 32) return false; L = 800 + (c - 32); } else if (i == 6) { if (c < 64) return false; L = 928 + (c - 64); } else return false;
        if (!pg8::static_tile_lin(L, nM, nN, pm, pn)) return false;
        u.A = A + (size_t)pm * 256 * lda; u.B = B + (size_t)pn * 256 * ldb; u.pm = pm; u.pn = pn; u.aux = 0; u.rows = 256; u.keep = 0; return true; }
    DI void a_off(const Unit&, const int (&R)[2], const int (&C)[2], unsigned (&v)[4]) const {
#pragma unroll
        for (int h = 0; h < 2; ++h)
#pragma unroll
            for (int i = 0; i < 2; ++i) v[h * 2 + i] = (unsigned)(h * 128 + R[i]) * lda + (unsigned)C[i] * 2u; }
};

template <bool FP8> struct Epi1 {
    unsigned char* ws; const float* bmg;
    static constexpr bool PRE = FP8; LAS unsigned char* lds;
    DI void pre(const Unit& u, LAS unsigned char* slot) const {
        const int l = threadIdx.x & 63; __builtin_amdgcn_global_load_lds((const unsigned*)(bmg + (tileB_old(u.pn) - 23) * 256 + l * 4), (LAS unsigned*)slot, 16, 0, 0); }
    DI void operator()(const Acc& acc_, const Unit& u, int wr, int wc, int fr, int fq) const {
        const Acc& acc = acc_;
        const int t = FP8 ? tileB_old(u.pn) : tileA_old(u.pn), row0 = u.pm * 256 + wr * 64 + fr, x0 = wc * 32 + fq * 8;
        if (!FP8 && t < 10) {
            const int hd = wc >> 1, dlo = (wc & 1) * 32 + fq * 8;
            const bool isq = t < 4, rope = t == 6 || t == 8;
            const f32x2* tab = (const f32x2*)(ws + WS_TAB);
#pragma unroll
            for (int ai = 0; ai < 2; ++ai)
#pragma unroll
                for (int m = 0; m < 4; ++m) {
                    const int row = row0 + ai * 128 + m * 16, s = row & (SEQ - 1), b = row >> 11;
                    const f32x4 a0 = acc[ai][0][m][0], a1 = acc[ai][0][m][1], b0 = acc[ai][1][m][0], b1 = acc[ai][1][m][1];
                    f32x4 l0 = a0, l1 = a1, h0 = b0, h1 = b1;
                    if (rope) {
                        const f32x4* tp = (const f32x4*)(tab + s * 64 + dlo);
                        const f32x4 c01 = tp[0], c23 = tp[1], c45 = tp[2], c67 = tp[3];
                        l0[0] = a0[0] * c01[0] - b0[0] * c01[1]; h0[0] = b0[0] * c01[0] + a0[0] * c01[1];
                        l0[1] = a0[1] * c01[2] - b0[1] * c01[3]; h0[1] = b0[1] * c01[2] + a0[1] * c01[3];
                        l0[2] = a0[2] * c23[0] - b0[2] * c23[1]; h0[2] = b0[2] * c23[0] + a0[2] * c23[1];
                        l0[3] = a0[3] * c23[2] - b0[3] * c23[3]; h0[3] = b0[3] * c23[2] + a0[3] * c23[3];
                        l1[0] = a1[0] * c45[0] - b1[0] * c45[1]; h1[0] = b1[0] * c45[0] + a1[0] * c45[1];
                        l1[1] = a1[1] * c45[2] - b1[1] * c45[3]; h1[1] = b1[1] * c45[2] + a1[1] * c45[3];
                        l1[2] = a1[2] * c67[0] - b1[2] * c67[1]; h1[2] = b1[2] * c67[0] + a1[2] * c67[1];
                        l1[3] = a1[3] * c67[2] - b1[3] * c67[3]; h1[3] = b1[3] * c67[2] + a1[3] * c67[3];
                    }
                    if (isq) {
                        const size_t o = (size_t)row * 1024 + (2 * t + hd) * 128 + dlo;
                        bf16_t* qraw = (bf16_t*)(ws + WS_QRAW) + o;
                        st8(qraw, a0, a1); st8(qraw + 64, b0, b1);
                    } else {
                        bf16_t* kv = (bf16_t*)(ws + WS_KV + (size_t)(t - 4) * KV_STRIDE) + ((size_t)((b * 2 + hd) * SEQ + s)) * 128 + dlo;
                        st8(kv, l0, l1); st8(kv + 64, h0, h1);
                    }
                }
        } else if (!FP8 && t < 22) {
            bf16_t* base; int ldc, c0;
            if (t < 12) { base = (bf16_t*)(ws + WS_QG); ldc = 512; c0 = (t - 10) * 256; }
            else if (t < 14) { base = (bf16_t*)(ws + WS_KG); ldc = 512; c0 = (t - 12) * 256; }
            else if (t < 18) { base = (bf16_t*)(ws + WS_VG); ldc = 1024; c0 = (t - 14) * 256; }
            else { base = (bf16_t*)(ws + WS_RG); ldc = 1024; c0 = (t - 18) * 256; }
#pragma unroll
            for (int ai = 0; ai < 2; ++ai)
#pragma unroll
                for (int m = 0; m < 4; ++m) { bf16_t* rp = base + (size_t)(row0 + ai * 128 + m * 16) * ldc + c0 + x0;
#pragma unroll
                    for (int bj = 0; bj < 2; ++bj) st8(rp + bj * 128, acc[ai][bj][m][0], acc[ai][bj][m][1]); }
        } else if (!FP8 && t == 22) {
            if (wc < 2) {
#pragma unroll
                for (int ai = 0; ai < 2; ++ai)
#pragma unroll
                    for (int m = 0; m < 4; ++m) { float* rp = (float*)(ws + WS_SMALL) + (size_t)(row0 + ai * 128 + m * 16) * 64 + x0;
                        *(f32x4*)rp = acc[ai][0][m][0]; *(f32x4*)(rp + 4) = acc[ai][0][m][1]; }
            }
        } else {
            const int c0 = (t - 23) * 256 + x0;
            f32x4 bv[2][2];
#pragma unroll
            for (int bj = 0; bj < 2; ++bj)
#pragma unroll
                for (int n = 0; n < 2; ++n) bv[bj][n] = (FP8 ? *(const LAS f32x4*)((const LAS float*)(lds + pg8::PRE_OFF + 1024 * u.par) + x0 + bj * 128 + 4 * n) : *(const f32x4*)(bmg + c0 + bj * 128 + 4 * n)) * -1.4426950408889634f;
            float ws_ = (FP8 ? W8_INV : 1.0f) * -1.4426950408889634f; asm volatile("" : "+v"(ws_));
            float k255 = 1.0f / 255.0f; asm volatile("" : "+v"(k255));
#pragma unroll
            for (int ai = 0; ai < 2; ++ai)
#pragma unroll
                for (int m = 0; m < 4; ++m) { unsigned char* rp = ws + WS_MG + (size_t)(row0 + ai * 128 + m * 16) * 4096 + (t - 23) * 256 + wc * 64 + fq * 16;
                    u32x4 w4;
#pragma unroll
                    for (int bj = 0; bj < 2; ++bj) { u32x2 w;
#pragma unroll
                        for (int n = 0; n < 2; ++n) {
                            const f32x4 tq = acc[ai][bj][m][n] * ws_ + bv[bj][n]; unsigned q = 0u;
#pragma unroll
                            for (int i = 0; i < 4; ++i) { const float e = __builtin_amdgcn_exp2f(tq[i]); q = __builtin_amdgcn_cvt_pk_u8_f32(__builtin_amdgcn_rcpf(__builtin_fmaf(e, k255, k255)), i, q); }
                            if (n == 0) w.x = q; else w.y = q; }
                        if (bj == 0) { w4.x = w.x; w4.y = w.y; } else { w4.z = w.x; w4.w = w.y; } }
                    *(u32x4*)rp = w4; }
        }
    }
};
struct SchedProj {
    static constexpr bool A_PER_UNIT = false;
    const char* A; const char* B; int G, c;
    DI bool next(int i, Unit& u) const { int pm, pn; if (!pg8::static_tile(i >> 1, G, c, 64, 8, pm, pn)) return false; const int half = i & 1;
        u.A = A + (size_t)pm * 256 * 4096 + half * 2048; u.B = B + (size_t)pn * 256 * 4096 + half * 2048; u.pm = pm; u.pn = pn; u.aux = half; u.rows = 256; u.keep = half == 0; return true; }
    DI void a_off(const Unit&, const int (&R)[2], const int (&C)[2], unsigned (&v)[4]) const {
#pragma unroll
        for (int h = 0; h < 2; ++h)
#pragma unroll
            for (int i = 0; i < 2; ++i) v[h * 2 + i] = (unsigned)(h * 128 + R[i]) * 4096u + (unsigned)C[i] * 2u; }
};
struct EpiProjF {
    unsigned char* ws;
    DI void operator()(Acc& acc, const Unit& u, int wr, int wc, int fr, int fq) const {
        const int row0 = u.pm * 256 + wr * 64 + fr, c0 = u.pn * 256 + wc * 32 + fq * 8, cp = u.pn * 256 + wc * 64 + fq * 16;
        const unsigned char* mg = ws + WS_MG;
        if (u.aux == 0) {
#pragma unroll
            for (int ai = 0; ai < 2; ++ai)
#pragma unroll
                for (int m = 0; m < 4; ++m) { const unsigned char* gp = mg + (size_t)(row0 + ai * 128 + m * 16) * 4096 + cp;
                    const u32x4 G1 = *(const u32x4*)gp, G2 = *(const u32x4*)(gp + 2048);
#pragma unroll
                    for (int bj = 0; bj < 2; ++bj) { const u32x2 g1 = bj ? (u32x2){G1.z, G1.w} : (u32x2){G1.x, G1.y}, g2 = bj ? (u32x2){G2.z, G2.w} : (u32x2){G2.x, G2.y};
                        f32x4& v0 = acc[ai][bj][m][0]; f32x4& v1 = acc[ai][bj][m][1];
#pragma unroll
                        for (int i = 0; i < 4; ++i) {
                            v0[i] *= (float)((g1.x >> (8 * i)) & 255u) * __builtin_amdgcn_rcpf(fmaxf((float)((g2.x >> (8 * i)) & 255u), 0.5f));
                            v1[i] *= (float)((g1.y >> (8 * i)) & 255u) * __builtin_amdgcn_rcpf(fmaxf((float)((g2.y >> (8 * i)) & 255u), 0.5f)); } } }
        } else {
#pragma unroll
            for (int ai = 0; ai < 2; ++ai)
#pragma unroll
                for (int m = 0; m < 4; ++m) { const size_t row = (size_t)(row0 + ai * 128 + m * 16);
                    const u32x4 G = *(const u32x4*)(mg + row * 4096 + 2048 + cp); bf16_t* op = (bf16_t*)(ws + WS_MIXED) + row * 2048 + c0;
#pragma unroll
                    for (int bj = 0; bj < 2; ++bj) { const u32x2 g = bj ? (u32x2){G.z, G.w} : (u32x2){G.x, G.y};
                        f32x4 v0 = acc[ai][bj][m][0], v1 = acc[ai][bj][m][1];
#pragma unroll
                        for (int i = 0; i < 4; ++i) { v0[i] *= fmaxf((float)((g.x >> (8 * i)) & 255u), 0.5f) * (1.0f / 255.0f); v1[i] *= fmaxf((float)((g.y >> (8 * i)) & 255u), 0.5f) * (1.0f / 255.0f); }
                        st8(op + bj * 128, v0, v1); } }
        }
    }
};
struct EpiOut {
    const float* x; bf16_t* x2; float* ssqp;
    DI void operator()(const Acc& acc, const Unit& u, int wr, int wc, int fr, int fq) const {
        const int row0 = u.pm * 256 + wr * 64 + fr, c0 = u.pn * 256 + wc * 32 + fq * 8;
#pragma unroll
        for (int ai = 0; ai < 2; ++ai)
#pragma unroll
            for (int m = 0; m < 4; ++m) { const size_t o = (size_t)(row0 + ai * 128 + m * 16) * 2048 + c0; float ss = 0.f;
#pragma unroll
                for (int bj = 0; bj < 2; ++bj) {
                    const f32x4 v0 = acc[ai][bj][m][0] + __builtin_nontemporal_load((const f32x4*)(x + o + bj * 128)), v1 = acc[ai][bj][m][1] + __builtin_nontemporal_load((const f32x4*)(x + o + bj * 128 + 4));
                    st8(x2 + o + bj * 128, v0, v1);
                    ss += (v0[0] * v0[0] + v0[1] * v0[1]) + (v0[2] * v0[2] + v0[3] * v0[3]) + (v1[0] * v1[0] + v1[1] * v1[1]) + (v1[2] * v1[2] + v1[3] * v1[3]); }
                ss += __shfl_xor(ss, 16); ss += __shfl_xor(ss, 32);
                if (fq == 0) ssqp[(size_t)(row0 + ai * 128 + m * 16) * 32 + u.pn * 4 + wc] = ss; }
    }
};

DI void moe_table(const Frame& F) {
    LAS int* tb = (LAS int*)(F.lds + LDS_TAB);
    if (F.tid < 32) tb[F.tid] = (int)__hip_atomic_load(F.ctl + CW_CNT + 64 * F.tid, __ATOMIC_RELAXED, __HIP_MEMORY_SCOPE_AGENT);
    __syncthreads();
    if (F.tid == 0) { int s = 0; for (int e = 0; e < 32; ++e) { tb[32 + e] = s; s += (tb[e] + 255) >> 8; } tb[64] = s; }
    __syncthreads();
    if (F.tid < 32) { const int b0 = tb[32 + F.tid], b1 = tb[33 + F.tid]; for (int b = b0; b < b1; ++b) tb[72 + b] = F.tid; }
    __syncthreads();
}

DI void p7_router(const Params& P, const Frame& F) {
    unsigned char* ws = P.ws;
    LAS float* part = (LAS float*)(F.lds + 512);
    constexpr int P7B = 512 + 65536;
    LAS float* rsl = (LAS float*)(F.lds + P7B + 3072);
    const bf16_t* x2 = (const bf16_t*)(ws + WS_X2); const float* gain = P.in[I_NORM_MOE];
    unsigned char* hn2 = ws + WS_HN2;
    const bf16_t* wrt = (const bf16_t*)(ws + WS_WRT);
    int* stok = (int*)(ws + WS_STOK); int* trec = (int*)(ws + WS_TREC);
    const int lane = F.lane, w = F.wave, tl = lane & 15, g = lane >> 4;
    for (int unit = F.bid; unit < NTOK / 64; unit += F.G) {
        const int t0 = unit * 64;
        { const f32x4 v = *(const f32x4*)((const float*)(ws + WS_SSQP) + (size_t)(t0 + 8 * w + (lane >> 3)) * 32 + (lane & 7) * 4);
          float ssq = (v[0] + v[1]) + (v[2] + v[3]); ssq += __shfl_xor(ssq, 1); ssq += __shfl_xor(ssq, 2); ssq += __shfl_xor(ssq, 4);
          if ((lane & 7) == 0) rsl[8 * w + (lane >> 3)] = __builtin_amdgcn_rsqf(ssq * (1.0f / 2048.0f) + NORM_EPS); }
        __syncthreads();
        {
            const bf16_t* xb = x2 + (size_t)(t0 + tl) * DM + 256 * w + 16 * g;
            const bf16_t* bh = wrt + (size_t)tl * DM + 256 * w + 16 * g; const bf16_t* bl = bh + NEXP * DM;
            const float* gp = gain + 256 * w + 16 * g;
            unsigned char* hp = hn2 + (size_t)(t0 + tl) * DM + 256 * w + 16 * g;
            float rs4[4];
#pragma unroll
            for (int tg = 0; tg < 4; ++tg) rs4[tg] = rsl[16 * tg + tl];
            f32x4 acc[4][2];
#pragma unroll
            for (int tg = 0; tg < 4; ++tg) { acc[tg][0] = (f32x4){0.f, 0.f, 0.f, 0.f}; acc[tg][1] = (f32x4){0.f, 0.f, 0.f, 0.f}; }
#pragma unroll 1
            for (int hf = 0; hf < 2; ++hf) {
                bf16x8 X[4][4], W[4][4]; f32x4 G[4][2];
#pragma unroll
                for (int ks = 0; ks < 4; ++ks) { const int o = 128 * hf + 64 * (ks >> 1) + 8 * (ks & 1);
                    W[ks][0] = *(const bf16x8*)(bh + o); W[ks][1] = *(const bf16x8*)(bh + 16 * DM + o); W[ks][2] = *(const bf16x8*)(bl + o); W[ks][3] = *(const bf16x8*)(bl + 16 * DM + o);
                    G[ks][0] = *(const f32x4*)(gp + o); G[ks][1] = *(const f32x4*)(gp + o + 4);
#pragma unroll
                    for (int tg = 0; tg < 4; ++tg) X[ks][tg] = *(const bf16x8*)(xb + (size_t)(16 * tg) * DM + o); }
#pragma unroll
                for (int kp = 0; kp < 2; ++kp)
#pragma unroll
                    for (int tg = 0; tg < 4; ++tg) { u32x4 f8; const float rs = rs4[tg];
#pragma unroll
                        for (int s = 0; s < 2; ++s) { const int ks = 2 * kp + s;
                            acc[tg][0] = __builtin_amdgcn_mfma_f32_16x16x32_bf16(X[ks][tg], W[ks][0], acc[tg][0], 0, 0, 0); acc[tg][1] = __builtin_amdgcn_mfma_f32_16x16x32_bf16(X[ks][tg], W[ks][1], acc[tg][1], 0, 0, 0);
                            acc[tg][0] = __builtin_amdgcn_mfma_f32_16x16x32_bf16(X[ks][tg], W[ks][2], acc[tg][0], 0, 0, 0); acc[tg][1] = __builtin_amdgcn_mfma_f32_16x16x32_bf16(X[ks][tg], W[ks][3], acc[tg][1], 0, 0, 0);
                            const u32x4 xq = __builtin_bit_cast(u32x4, X[ks][tg]);
                            const unsigned lo = pk4_fp8(bflo(xq.x) * rs * G[ks][0][0], bfhi(xq.x) * rs * G[ks][0][1], bflo(xq.y) * rs * G[ks][0][2], bfhi(xq.y) * rs * G[ks][0][3]);
                            const unsigned hi = pk4_fp8(bflo(xq.z) * rs * G[ks][1][0], bfhi(xq.z) * rs * G[ks][1][1], bflo(xq.w) * rs * G[ks][1][2], bfhi(xq.w) * rs * G[ks][1][3]);
                            if (s == 0) { f8.x = lo; f8.y = hi; } else { f8.z = lo; f8.w = hi; } }
                        *(u32x4*)(hp + (size_t)(16 * tg) * DM + 128 * hf + 64 * kp) = f8;
                    }
            }
#pragma unroll
            for (int tg = 0; tg < 4; ++tg)
#pragma unroll
                for (int r = 0; r < 4; ++r) { part[(w * 64 + 16 * tg + 4 * g + r) * 32 + tl] = acc[tg][0][r]; part[(w * 64 + 16 * tg + 4 * g + r) * 32 + 16 + tl] = acc[tg][1][r]; }
        }
        __syncthreads();
        LAS int* sel_e = (LAS int*)(F.lds + P7B);
        LAS float* sel_w = (LAS float*)(F.lds + P7B + 1024);
        LAS int* lcnt = (LAS int*)(F.lds + P7B + 2048);
        if (F.tid < 32) lcnt[F.tid] = 0;
#pragma unroll 1
        for (int st = 0; st < 4; ++st) {
            const int tloc = 8 * w + 2 * st + (lane >> 5), e = lane & 31;
            float lsum = 0.f;
#pragma unroll
            for (int kq = 0; kq < 8; ++kq) lsum += part[(kq * 64 + tloc) * 32 + e];
            const float lg = P.in[I_BR][e] + rsl[tloc] * lsum;
            float cur = lg; float selv[4]; int sele[4];
#pragma unroll
            for (int k = 0; k < 4; ++k) {
                float bv = cur; int be = e;
#pragma unroll
                for (int o = 16; o > 0; o >>= 1) { const float ov = __shfl_xor(bv, o); const int oe = __shfl_xor(be, o); if (ov > bv || (ov == bv && oe < be)) { bv = ov; be = oe; } }
                selv[k] = bv; sele[k] = be; if (e == be) cur = -__builtin_inff();
            }
            const float m = selv[0]; float ex[4], s = 0.f;
#pragma unroll
            for (int k = 0; k < 4; ++k) { ex[k] = __expf(selv[k] - m); s += ex[k]; }
            const float inv = 1.0f / s;
            if (e < 4) {
                sel_e[tloc * 4 + e] = e == 0 ? sele[0] : (e == 1 ? sele[1] : (e == 2 ? sele[2] : sele[3]));
                sel_w[tloc * 4 + e] = (e == 0 ? ex[0] : (e == 1 ? ex[1] : (e == 2 ? ex[2] : ex[3]))) * inv;
            }
        }
        __syncthreads();
        int my_e = 0, my_lr = 0;
        if (F.tid < 256) { my_e = sel_e[F.tid]; my_lr = __hip_atomic_fetch_add(lcnt + my_e, 1, __ATOMIC_RELAXED, __HIP_MEMORY_SCOPE_WORKGROUP); }
        __syncthreads();
        if (F.tid < 32) { const int c = lcnt[F.tid]; lcnt[32 + F.tid] = c ? (int)__hip_atomic_fetch_add(F.ctl + CW_CNT + 64 * F.tid, (unsigned)c, __ATOMIC_RELAXED, __HIP_MEMORY_SCOPE_AGENT) : 0; }
        __syncthreads();
        if (F.tid < 256) {
            const int rank = lcnt[32 + my_e] + my_lr, tk = t0 + (F.tid >> 2);
            stok[(size_t)my_e * ECAP + rank] = tk;
            int* tr = trec + ((size_t)tk * 4 + (F.tid & 3)) * 4; tr[0] = my_e; tr[1] = rank; tr[2] = __float_as_int(sel_w[F.tid]); tr[3] = 0;
        }
        __syncthreads();
    }
}

struct SchedGU {
    static constexpr bool A_PER_UNIT = true;
    const char* hn2; const char* wgu; const int* stok; LAS int* tb; int G, c;
    DI bool next(int i, Unit& u) const { const int nblk = __builtin_amdgcn_readfirstlane(tb[64]); int blk, pn;
        { const int L = i * G + c; blk = L >> 4; pn = L & 15; }
        if (blk >= nblk) return false;
        const int e = __builtin_amdgcn_readfirstlane(tb[72 + blk]), r0 = (blk - __builtin_amdgcn_readfirstlane(tb[32 + e])) * 256;
        u.A = hn2; u.B = wgu + ((size_t)e * 4096 + pn * 256) * 2048; u.pm = blk; u.pn = pn; u.aux = e; u.rows = r0; u.keep = 0; return true; }
    DI void a_off(const Unit& u, const int (&R)[2], const int (&C)[2], unsigned (&v)[4]) const {
        const int ce = __builtin_amdgcn_readfirstlane(tb[u.aux]); const int* st = stok + (size_t)u.aux * ECAP;
#pragma unroll
        for (int h = 0; h < 2; ++h)
#pragma unroll
            for (int i = 0; i < 2; ++i) { int idx = u.rows + h * 128 + R[i]; idx = idx < ce ? idx : 0; v[h * 2 + i] = (unsigned)st[idx] * 2048u + (unsigned)C[i] * 2u; }
    }
};
struct EpiGU {
    unsigned char* act; const float* bgu;
    static constexpr bool PRE = true; LAS unsigned char* lds;
    DI void pre(const Unit& u, LAS unsigned char* slot) const {
        const int l = threadIdx.x & 63; const float* src = bgu + (size_t)u.aux * 4096 + u.pn * 128 + (l >> 5) * 2048 + (l & 31) * 4;
        __builtin_amdgcn_global_load_lds((const unsigned*)src, (LAS unsigned*)slot, 16, 0, 0); }
    static DI f32x4 swiglu(f32x4 g, f32x4 u) {
        f32x4 ga, ua;
#pragma unroll
        for (int i = 0; i < 4; ++i) { ga[i] = fminf(g[i], 7.0f); ua[i] = __builtin_amdgcn_fmed3f(u[i], -7.0f, 7.0f); }
        const f32x4 t = ga * (-1.702f * 1.4426950408889634f); f32x4 e;
#pragma unroll
        for (int i = 0; i < 4; ++i) e[i] = __builtin_amdgcn_exp2f(t[i]);
        const f32x4 d = e + 1.0f; f32x4 r;
#pragma unroll
        for (int i = 0; i < 4; ++i) r[i] = __builtin_amdgcn_rcpf(d[i]);
        return (ua + 1.0f) * (ga * r);
    }
    DI void operator()(const Acc& acc, const Unit& u, int wr, int wc, int fr, int fq) const {
        const int row0 = u.pm * 256 + wr * 64 + fr, x0 = u.pn * 128 + wc * 32 + fq * 8;
        const LAS float* bp = (const LAS float*)(lds + pg8::PRE_OFF + 1024 * u.par) + wc * 32 + fq * 8;
        const f32x4 bg0 = *(const LAS f32x4*)bp, bg1 = *(const LAS f32x4*)(bp + 4), bu0 = *(const LAS f32x4*)(bp + 128), bu1 = *(const LAS f32x4*)(bp + 132);
        float winv = W8_INV; asm volatile("" : "+v"(winv));
#pragma unroll
        for (int ai = 0; ai < 2; ++ai)
#pragma unroll
            for (int m = 0; m < 4; ++m) {
                const f32x4 o0 = swiglu(acc[ai][0][m][0] * winv + bg0, acc[ai][1][m][0] * winv + bu0), o1 = swiglu(acc[ai][0][m][1] * winv + bg1, acc[ai][1][m][1] * winv + bu1);
                u32x2 w8; w8.x = pk4_fp8(o0[0], o0[1], o0[2], o0[3]); w8.y = pk4_fp8(o1[0], o1[1], o1[2], o1[3]);
                *(u32x2*)(act + (size_t)(row0 + ai * 128 + m * 16) * 2048 + x0) = w8;
            }
    }
};
struct SchedDN {
    static constexpr bool A_PER_UNIT = false;
    const char* act; const char* wdn; LAS int* tb; int G, c;
    DI bool next(int i, Unit& u) const { const int nblk = __builtin_amdgcn_readfirstlane(tb[64]); int blk, pn;
        { const int L = i * G + c; blk = L >> 3; pn = L & 7; }
        if (blk >= nblk) return false;
        const int e = __builtin_amdgcn_readfirstlane(tb[72 + blk]);
        u.A = act + (size_t)blk * 256 * 2048; u.B = wdn + ((size_t)e * 2048 + pn * 256) * 2048; u.pm = blk; u.pn = pn; u.aux = e; u.rows = 256; u.keep = 0; return true; }
    DI void a_off(const Unit&, const int (&R)[2], const int (&C)[2], unsigned (&v)[4]) const {
#pragma unroll
        for (int h = 0; h < 2; ++h)
#pragma unroll
            for (int i = 0; i < 2; ++i) v[h * 2 + i] = (unsigned)(h * 128 + R[i]) * 2048u + (unsigned)C[i] * 2u; }
};
struct EpiDN {
    unsigned char* eo; const float* bdn;
    static constexpr bool PRE = true; LAS unsigned char* lds;
    DI void pre(const Unit& u, LAS unsigned char* slot) const {
        const int l = threadIdx.x & 63; __builtin_amdgcn_global_load_lds((const unsigned*)(bdn + (size_t)u.aux * 2048 + u.pn * 256 + l * 4), (LAS unsigned*)slot, 16, 0, 0); }
    DI void operator()(const Acc& acc, const Unit& u, int wr, int wc, int fr, int fq) const {
        const int row0 = u.pm * 256 + wr * 64 + fr, c0 = u.pn * 256 + wc * 32 + fq * 8;
        const LAS float* bp = (const LAS float*)(lds + pg8::PRE_OFF + 1024 * u.par) + wc * 32 + fq * 8;
        float winv = W8_INV; asm volatile("" : "+v"(winv));
        f32x4 bv[2][2];
#pragma unroll
        for (int bj = 0; bj < 2; ++bj)
#pragma unroll
            for (int n = 0; n < 2; ++n) bv[bj][n] = *(const LAS f32x4*)(bp + bj * 128 + 4 * n);
#pragma unroll
        for (int ai = 0; ai < 2; ++ai)
#pragma unroll
            for (int m = 0; m < 4; ++m) { unsigned char* rp = eo + (size_t)(row0 + ai * 128 + m * 16) * 2048 + u.pn * 256 + wc * 64 + fq * 16;
                u32x4 w4;
#pragma unroll
                for (int bj = 0; bj < 2; ++bj) { const f32x4 v0 = acc[ai][bj][m][0] * winv + bv[bj][0], v1 = acc[ai][bj][m][1] * winv + bv[bj][1];
                    const unsigned lo = pk4_fp8(v0[0], v0[1], v0[2], v0[3]), hi = pk4_fp8(v1[0], v1[1], v1[2], v1[3]); if (bj == 0) { w4.x = lo; w4.y = hi; } else { w4.z = lo; w4.w = hi; } }
                *(u32x4*)rp = w4; }
    }
};
DI void p10_final(const Params& P, const Frame& F) {
    unsigned char* ws = P.ws; LAS int* tb = (LAS int*)(F.lds + LDS_TAB);
    const bf16_t* x2 = (const bf16_t*)(ws + WS_X2); const unsigned char* eo = ws + WS_EO; const int* trec = (const int*)(ws + WS_TREC);
    const float* gain = P.in[I_NORM_FINAL]; const int lane = F.lane;
    int eoff[8];
#pragma unroll
    for (int i = 0; i < 8; ++i) { const int c = (i * 64 + lane) * 4, cl = c & 255; eoff[i] = (c & ~255) + ((cl >> 5) & 3) * 64 + ((cl >> 3) & 3) * 16 + (cl >> 7) * 8 + (cl & 7); }
    for (int tok = F.bid * 8 + F.wave; tok < NTOK; tok += F.G * 8) {
        const bf16_t* x = x2 + (size_t)tok * DM;
        f32x4 v[8];
#pragma unroll
        for (int i = 0; i < 8; ++i) { const u32x2 q = __builtin_nontemporal_load((const u32x2*)(x + (i * 64 + lane) * 4)); v[i] = (f32x4){bflo(q.x), bfhi(q.x), bflo(q.y), bfhi(q.y)}; }
#pragma unroll
        for (int k = 0; k < 4; ++k) {
            const int* tr = trec + ((size_t)tok * 4 + k) * 4; const int e = tr[0], rank = tr[1]; const float wv = __int_as_float(tr[2]);
            const unsigned char* er = eo + ((size_t)tb[32 + e] * 256 + rank) * 2048;
#pragma unroll
            for (int i = 0; i < 8; ++i) { const int q = __builtin_nontemporal_load((const int*)(er + eoff[i]));
                const f32x2 lo = __builtin_amdgcn_cvt_pk_f32_fp8(q, false), hi = __builtin_amdgcn_cvt_pk_f32_fp8(q, true);
                v[i][0] += wv * lo[0]; v[i][1] += wv * lo[1]; v[i][2] += wv * hi[0]; v[i][3] += wv * hi[1]; }
        }
        float ss = 0.f;
#pragma unroll
        for (int i = 0; i < 8; ++i) ss += v[i][0] * v[i][0] + v[i][1] * v[i][1] + v[i][2] * v[i][2] + v[i][3] * v[i][3];
        ss = wave_sum(ss); const float rs = __builtin_amdgcn_rsqf(ss * (1.0f / 2048.0f) + NORM_EPS);
        float* o = P.out + (size_t)tok * DM;
#pragma unroll
        for (int i = 0; i < 8; ++i) { const f32x4 g = *(const f32x4*)(gain + (i * 64 + lane) * 4); __builtin_nontemporal_store(v[i] * rs * g, (f32x4*)(o + (i * 64 + lane) * 4)); }
    }
}
typedef short v4i16_t __attribute__((ext_vector_type(4)));
DI s16x4 ld_tr(const LAS unsigned char* p) { return __builtin_bit_cast(s16x4, __builtin_amdgcn_ds_read_tr16_b64_v4i16((LAS v4i16_t*)p)); }
DI bf16x8 cat8(s16x4 a, s16x4 b) { return __builtin_shufflevector(a, b, 0, 1, 2, 3, 4, 5, 6, 7); }

struct SchedCmp {
    static constexpr bool A_PER_UNIT = false;
    unsigned char* ws; int G, c;
    DI bool next(int i, Unit& u) const { const int L = c; if (i > 0 || L >= 256) return false;
        const int kv = L >> 7, pm = (L >> 4) & 7, s = L & 15;
        u.A = (const char*)(ws + WS_KV + (size_t)kv * KV_STRIDE) + s * 512; u.B = (const char*)(ws + (kv ? WS_WCV1 : WS_WCK1)) + s * 512; u.pm = pm; u.pn = 0; u.aux = kv * 16 + s; u.rows = 256; u.keep = 0; return true; }
    DI void a_off(const Unit& u, const int (&R)[2], const int (&C)[2], unsigned (&v)[4]) const {
#pragma unroll
        for (int h = 0; h < 2; ++h)
#pragma unroll
            for (int i = 0; i < 2; ++i) { int r = u.pm * 256 + h * 128 + R[i]; r = r < 2032 ? r : 2031; const int bg = r / 127, n = r - bg * 127;
                v[h * 2 + i] = (unsigned)((bg * SEQ + n * 16) * 128 + C[i]) * 2u; }
    }
};
struct EpiCmp {
    bf16_t* part;
    DI void operator()(const Acc& acc, const Unit& u, int wr, int wc, int fr, int fq) const {
        const int row0 = u.pm * 256 + wr * 64 + fr, x0 = wc * 32 + fq * 8;
#pragma unroll
        for (int ai = 0; ai < 2; ++ai)
#pragma unroll
            for (int m = 0; m < 4; ++m) { bf16_t* rp = part + ((size_t)u.aux * 2048 + row0 + ai * 128 + m * 16) * 256 + x0;
#pragma unroll
                for (int bj = 0; bj < 2; ++bj) st8(rp + bj * 128, acc[ai][bj][m][0], acc[ai][bj][m][1]); }
    }
};
DI float gelu_tanh(float x) { const float y = 0.7978845608028654f * (x + 0.044715f * x * x * x); const float t = 1.0f - 2.0f * __builtin_amdgcn_rcpf(1.0f + __expf(2.0f * y)); return 0.5f * x * (1.0f + t); }
DI void cmp_stage2(const Params& P, const Frame& F) {
    unsigned char* ws = P.ws; LAS float* hid = (LAS float*)F.lds;
    const bf16_t* part = (const bf16_t*)(ws + WS_CPART); const float* cb = (const float*)(ws + WS_CBIAS);
    bf16_t* kc = (bf16_t*)(ws + WS_KCMP);
    if (F.bid < 32 && F.tid < 128) kc[((size_t)F.bid * 128 + 127) * 128 + F.tid] = 0;
    for (int blk = F.bid; blk < 254; blk += F.G) {
        const int kv = blk >= 127, r0 = (blk - kv * 127) * 16;
        {
            const int c = F.tid & 255, rr0 = F.tid >> 8; float bsum = 0.f;
            for (int ch = 0; ch < 32; ++ch) bsum += cb[ch * 512 + kv * 256 + c];
#pragma unroll
            for (int q = 0; q < 8; ++q) { const int rr = rr0 + 2 * q; float s = bsum;
#pragma unroll
                for (int sp = 0; sp < 16; ++sp) s += bf2f(part[((size_t)(kv * 16 + sp) * 2048 + r0 + rr) * 256 + c]);
                hid[rr * 256 + c] = gelu_tanh(s); }
        }
        __syncthreads();
        {
            const int c = F.tid & 127, rg = F.tid >> 7; const float* w2 = P.in[kv ? I_WCV2 : I_WCK2];
            float a[4] = {0.f, 0.f, 0.f, 0.f};
#pragma unroll 4
            for (int k = 0; k < 256; ++k) { const float w = w2[k * 128 + c];
#pragma unroll
                for (int j = 0; j < 4; ++j) a[j] += hid[(rg * 4 + j) * 256 + k] * w; }
#pragma unroll
            for (int j = 0; j < 4; ++j) { const int r = r0 + rg * 4 + j; const int bg = r / 127, n = r - bg * 127; kc[(((size_t)kv * 16 + bg) * 128 + n) * 128 + c] = f2bf(a[j]); }
        }
        __syncthreads();
    }
}

constexpr int GP_STRIDE = 272;
DI void gla_prep(const Params& P, const Frame& F) {
    unsigned char* ws = P.ws;
    constexpr int GP_U = 2 * 64 * GP_STRIDE + 8192;
    const float* small = (const float*)(ws + WS_SMALL); const bf16_t* qg = (const bf16_t*)(ws + WS_QG); const bf16_t* kg = (const bf16_t*)(ws + WS_KG);
    bf16_t* gqt = (bf16_t*)(ws + WS_GQT); bf16_t* gks = (bf16_t*)(ws + WS_GKS); bf16_t* gatt = (bf16_t*)(ws + WS_GATT); float* gdec = (float*)(ws + WS_GDEC);
    const int d = 2 * (F.tid & 63), tg = F.tid >> 6, lane = F.lane, w = F.wave;
    for (int unit0 = 2 * F.bid; unit0 < NB * GLA_H * GNC; unit0 += 2 * F.G) {
        const int n0 = unit0 & 31, h = (unit0 >> 5) & 3, b = unit0 >> 7;
        f32x2 wa[16];
#pragma unroll
        for (int r = 0; r < 16; ++r) wa[r] = *(const f32x2*)(P.in[I_WGA] + r * 512 + h * 128 + d);
        const f32x2 ba = *(const f32x2*)(P.in[I_BGA] + h * 128 + d);
        f32x2 cl[2][8]; unsigned qk[2][8][2]; f32x2 ain[2];
#pragma unroll
        for (int u = 0; u < 2; ++u) { const int tok0 = b * SEQ + (n0 + u) * 64 + tg * 8;
            ain[u] = *(const f32x2*)(small + (size_t)(b * SEQ + (n0 + u) * 64 + (F.tid >> 3)) * 64 + 24 + 2 * (F.tid & 7));
#pragma unroll
            for (int j = 0; j < 8; ++j) { qk[u][j][0] = *(const unsigned*)(qg + (size_t)(tok0 + j) * 512 + h * 128 + d); qk[u][j][1] = *(const unsigned*)(kg + (size_t)(tok0 + j) * 512 + h * 128 + d); } }
#pragma unroll
        for (int u = 0; u < 2; ++u) *(LAS f32x2*)((LAS float*)(F.lds + u * GP_U + 2 * 64 * GP_STRIDE + 4096) + (F.tid >> 3) * 16 + 2 * (F.tid & 7)) = ain[u];
        __syncthreads();
#pragma unroll
        for (int u = 0; u < 2; ++u) { f32x2 run = {0.f, 0.f};
#pragma unroll
            for (int j = 0; j < 8; ++j) { f32x2 z = ba;
#pragma unroll
                for (int r4 = 0; r4 < 4; ++r4) { const f32x4 a4 = *(const LAS f32x4*)((const LAS float*)(F.lds + u * GP_U + 2 * 64 * GP_STRIDE + 4096) + (tg * 8 + j) * 16 + 4 * r4); z += wa[4 * r4] * a4[0] + wa[4 * r4 + 1] * a4[1] + wa[4 * r4 + 2] * a4[2] + wa[4 * r4 + 3] * a4[3]; }
                f32x2 ls; ls.x = fminf(z.x, 0.f) - __logf(1.0f + __expf(-fabsf(z.x))); ls.y = fminf(z.y, 0.f) - __logf(1.0f + __expf(-fabsf(z.y)));
                run += ls * (1.0f / 16.0f); cl[u][j] = run; }
            *(LAS f32x2*)((LAS float*)(F.lds + u * GP_U + 2 * 64 * GP_STRIDE) + tg * 128 + d) = run; }
        __syncthreads();
#pragma unroll
        for (int u = 0; u < 2; ++u) { const int unit = unit0 + u;
            LAS unsigned char* Ql = F.lds + u * GP_U; LAS unsigned char* Kl = Ql + 64 * GP_STRIDE; const LAS float* tot = (const LAS float*)(Ql + 2 * 64 * GP_STRIDE);
            f32x2 off = {0.f, 0.f}, last = {0.f, 0.f};
#pragma unroll
            for (int g = 0; g < 8; ++g) { const f32x2 tv = *(const LAS f32x2*)(tot + g * 128 + d); if (g < tg) off += tv; last += tv; }
            if (tg == 0) { f32x2 dv; dv.x = __expf(last.x); dv.y = __expf(last.y); *(f32x2*)(gdec + (size_t)unit * 128 + d) = dv; }
#pragma unroll
            for (int j = 0; j < 8; ++j) {
                const int sl = tg * 8 + j; const f32x2 cum = off + cl[u][j];
                const float q0 = bflo(qk[u][j][0]), q1 = bfhi(qk[u][j][0]), k0 = bflo(qk[u][j][1]), k1 = bfhi(qk[u][j][1]);
                const unsigned qt = cvt_pk_bf16(q0 * 0.08838834764831845f * __expf(cum.x), q1 * 0.08838834764831845f * __expf(cum.y));
                const unsigned kt = cvt_pk_bf16(k0 * __expf(-cum.x), k1 * __expf(-cum.y));
                const unsigned ks = cvt_pk_bf16(k0 * __expf(last.x - cum.x), k1 * __expf(last.y - cum.y));
                const size_t o = ((size_t)(b * GLA_H + h) * SEQ + (n0 + u) * 64 + sl) * 128 + d;
                *(unsigned*)(gqt + o) = qt; *(unsigned*)(gks + o) = ks;
                *(LAS unsigned*)(Ql + sl * GP_STRIDE + d * 2) = qt; *(LAS unsigned*)(Kl + sl * GP_STRIDE + d * 2) = kt;
            } }
        __syncthreads();
#pragma unroll
        for (int u = 0; u < 2; ++u) { const int unit = unit0 + u; const LAS unsigned char* Ql = F.lds + u * GP_U; const LAS unsigned char* Kl = Ql + 64 * GP_STRIDE;
#pragma unroll
            for (int q = 0; q < 2; ++q) {
                const int blk = 2 * w + q, bi = blk >> 2, bc = blk & 3, r = lane & 15, g = lane >> 4;
                f32x4 acc = {0.f, 0.f, 0.f, 0.f};
                if (bc <= bi) {
#pragma unroll
                    for (int ks = 0; ks < 4; ++ks) {
                        const bf16x8 a = *(const LAS bf16x8*)(Ql + (bi * 16 + r) * GP_STRIDE + (32 * ks + 8 * g) * 2);
                        const bf16x8 bb = *(const LAS bf16x8*)(Kl + (bc * 16 + r) * GP_STRIDE + (32 * ks + 8 * g) * 2);
                        acc = __builtin_amdgcn_mfma_f32_16x16x32_bf16(bb, a, acc, 0, 0, 0);
                    }
                }
                const int irow = bi * 16 + r, jc0 = bc * 16 + 4 * g;
                u32x2 o; o.x = cvt_pk_bf16(jc0 <= irow ? acc[0] : 0.f, jc0 + 1 <= irow ? acc[1] : 0.f); o.y = cvt_pk_bf16(jc0 + 2 <= irow ? acc[2] : 0.f, jc0 + 3 <= irow ? acc[3] : 0.f);
                *(u32x2*)(gatt + ((size_t)unit * 64 + irow) * 64 + jc0) = o;
            } }
        __syncthreads();
    }
}

constexpr int GS_QT = 0, GS_KS = 64 * 272, GS_ATT = 2 * 64 * 272, GS_V = GS_ATT + 64 * 144, GS_S = GS_V + 64 * 72, GS_GO = GS_S + 128 * 72, GS_END = GS_GO + 64 * 144;
DI void gla_scan(const Params& P, const Frame& F) {
    unsigned char* ws = P.ws; LAS unsigned char* L = F.lds;
    const bf16_t* gqt = (const bf16_t*)(ws + WS_GQT); const bf16_t* gks = (const bf16_t*)(ws + WS_GKS); const bf16_t* gatt = (const bf16_t*)(ws + WS_GATT);
    const bf16_t* vg = (const bf16_t*)(ws + WS_VG); const float* gdec = (const float*)(ws + WS_GDEC); float* go = (float*)(ws + WS_GO);
    const int tid = F.tid, lane = F.lane, w = F.wave, r = lane & 15, g = lane >> 4, q4 = (lane & 15) >> 2, p4 = lane & 3;
    for (int unit = F.bid; unit < NB * GLA_H * 8; unit += F.G) {
        const int dvs = unit & 7, h = (unit >> 3) & 3, b = unit >> 5;
        const size_t bh = (size_t)(b * GLA_H + h);
        f32x4 S0 = {0.f, 0.f, 0.f, 0.f}, S1 = {0.f, 0.f, 0.f, 0.f};
        for (int i = tid; i < 128 * 72 / 4; i += 512) ((LAS unsigned*)(L + GS_S))[i] = 0u;
        u32x4 rqA[2], rkA[2], raA, rvA, rqB[2], rkB[2], raB, rvB;
#define GS_LOAD(nn_, rq, rk, ra, rv) do { const int n_ = (nn_) < GNC ? (nn_) : GNC - 1; const size_t t0_ = (bh * SEQ + (n_) * 64) * 128; \
            _Pragma("unroll") for (int i_ = 0; i_ < 2; ++i_) { const int id_ = tid + 512 * i_; rq[i_] = *(const u32x4*)(gqt + t0_ + (size_t)id_ * 8); rk[i_] = *(const u32x4*)(gks + t0_ + (size_t)id_ * 8); } \
            ra = *(const u32x4*)(gatt + ((bh * GNC + (n_)) * 64) * 64 + (size_t)tid * 8); \
            rv = *(const u32x4*)(vg + ((size_t)(b * SEQ + (n_) * 64 + ((tid & 255) >> 2))) * 1024 + h * 256 + dvs * 32 + (tid & 3) * 8); } while (0)
#define GS_STORE(rq, rk, ra, rv) do { _Pragma("unroll") for (int i_ = 0; i_ < 2; ++i_) { const int id_ = tid + 512 * i_; \
                *(LAS u32x4*)(L + GS_QT + (id_ >> 4) * 272 + (id_ & 15) * 16) = rq[i_]; *(LAS u32x4*)(L + GS_KS + (id_ >> 4) * 272 + (id_ & 15) * 16) = rk[i_]; } \
            *(LAS u32x4*)(L + GS_ATT + (tid >> 3) * 144 + (tid & 7) * 16) = ra; \
            if (tid < 256) { *(LAS u32x2*)(L + GS_V + (tid >> 2) * 72 + (tid & 3) * 16) = (u32x2){rv.x, rv.y}; *(LAS u32x2*)(L + GS_V + (tid >> 2) * 72 + (tid & 3) * 16 + 8) = (u32x2){rv.z, rv.w}; } } while (0)
#define GS_CHUNK(n) do { \
            const f32x4 dec = decn; decn = *(const f32x4*)(gdec + ((bh * GNC + ((n) + 1 < GNC ? (n) + 1 : (n))) * 128) + 16 * w + 4 * g); \
            const int bi = w >> 1, bc = w & 1; \
            f32x4 o = {0.f, 0.f, 0.f, 0.f}; \
            _Pragma("unroll") for (int ks = 0; ks < 2; ++ks) { \
                const bf16x8 a = *(const LAS bf16x8*)(L + GS_ATT + (bi * 16 + r) * 144 + (32 * ks + 8 * g) * 2); \
                const LAS unsigned char* vp = L + GS_V + (32 * ks + 8 * g + q4) * 72 + (bc * 16 + 4 * p4) * 2; \
                const bf16x8 bb = cat8(ld_tr(vp), ld_tr(vp + 4 * 72)); \
                o = __builtin_amdgcn_mfma_f32_16x16x32_bf16(a, bb, o, 0, 0, 0); } \
            _Pragma("unroll") for (int ks = 0; ks < 4; ++ks) { \
                const bf16x8 a = *(const LAS bf16x8*)(L + GS_QT + (bi * 16 + r) * 272 + (32 * ks + 8 * g) * 2); \
                const LAS unsigned char* sp = L + GS_S + (32 * ks + 8 * g + q4) * 72 + (bc * 16 + 4 * p4) * 2; \
                const bf16x8 bb = cat8(ld_tr(sp), ld_tr(sp + 4 * 72)); \
                o = __builtin_amdgcn_mfma_f32_16x16x32_bf16(a, bb, o, 0, 0, 0); } \
            f32x4 n0 = S0 * dec, n1 = S1 * dec; \
            _Pragma("unroll") for (int ks = 0; ks < 2; ++ks) { \
                const LAS unsigned char* kp = L + GS_KS + (32 * ks + 8 * g + q4) * 272 + (16 * w + 4 * p4) * 2; \
                const bf16x8 a = cat8(ld_tr(kp), ld_tr(kp + 4 * 272)); \
                const LAS unsigned char* vp0 = L + GS_V + (32 * ks + 8 * g + q4) * 72 + (4 * p4) * 2; \
                const bf16x8 b0 = cat8(ld_tr(vp0), ld_tr(vp0 + 4 * 72)), b1 = cat8(ld_tr(vp0 + 32), ld_tr(vp0 + 32 + 4 * 72)); \
                n0 = __builtin_amdgcn_mfma_f32_16x16x32_bf16(a, b0, n0, 0, 0, 0); \
                n1 = __builtin_amdgcn_mfma_f32_16x16x32_bf16(a, b1, n1, 0, 0, 0); } \
            S0 = n0; S1 = n1; \
            _Pragma("unroll") for (int rg = 0; rg < 4; ++rg) *(LAS float*)(L + GS_GO + ((bi * 16 + 4 * g + rg) * 36 + bc * 16 + r) * 4) = o[rg]; \
            LDS_BARRIER(); \
            *(f32x4*)(go + ((size_t)(b * SEQ + (n) * 64 + (tid >> 3))) * 1024 + h * 256 + dvs * 32 + (tid & 7) * 4) = *(const LAS f32x4*)(L + GS_GO + ((tid >> 3) * 36 + (tid & 7) * 4) * 4);       \
            _Pragma("unroll") for (int rg = 0; rg < 4; ++rg) { *(LAS bf16_t*)(L + GS_S + (16 * w + 4 * g + rg) * 72 + r * 2) = f2bf(S0[rg]); *(LAS bf16_t*)(L + GS_S + (16 * w + 4 * g + rg) * 72 + (16 + r) * 2) = f2bf(S1[rg]); } } while (0)
        f32x4 decn = *(const f32x4*)(gdec + ((bh * GNC + 0) * 128) + 16 * w + 4 * g);
        GS_LOAD(0, rqA, rkA, raA, rvA); GS_LOAD(1, rqB, rkB, raB, rvB);
        LDS_BARRIER();
        GS_STORE(rqA, rkA, raA, rvA);
        for (int n = 0; n < GNC; n += 2) {
            LDS_BARRIER();
            GS_LOAD(n + 2, rqA, rkA, raA, rvA);
            GS_CHUNK(n);
            GS_STORE(rqB, rkB, raB, rvB);
            LDS_BARRIER();
            GS_LOAD(n + 3, rqB, rkB, raB, rvB);
            GS_CHUNK(n + 1);
            GS_STORE(rqA, rkA, raA, rvA);
        }
        LDS_BARRIER();
#undef GS_LOAD
#undef GS_STORE
#undef GS_CHUNK
    }
}
constexpr int G2_QT = 0, G2_KS = 64 * 272, G2_ATT = 2 * 64 * 272, G2_V = G2_ATT + 64 * 144, G2_DEC = G2_V + 64 * 72, G2_BUF = G2_DEC + 512;
DI void gla_scan2(const Params& P, const Frame& F) {
    unsigned char* ws = P.ws; LAS unsigned char* L = F.lds;
    const bf16_t* gqt = (const bf16_t*)(ws + WS_GQT); const bf16_t* gks = (const bf16_t*)(ws + WS_GKS); const bf16_t* gatt = (const bf16_t*)(ws + WS_GATT);
    const bf16_t* vg = (const bf16_t*)(ws + WS_VG); const float* gdec = (const float*)(ws + WS_GDEC); float* go = (float*)(ws + WS_GO);
    const int tid = F.tid, lane = F.lane, w = F.wave, r = lane & 15, g = lane >> 4, q4 = (lane & 15) >> 2, p4 = lane & 3, cw = w & 1, rh = w >> 1;
    for (int u0 = F.bid; u0 < NB * GLA_H * 8; u0 += F.G) {
        const int unit = (F.G == 256) ? (((u0 & 7) * 4 + (u0 >> 6)) * 8 + ((u0 >> 3) & 7)) : u0;
        const int dvs = unit & 7, h = (unit >> 3) & 3, b = unit >> 5;
        const size_t bh = (size_t)(b * GLA_H + h);
        f32x4 S[8];
#pragma unroll
        for (int kb = 0; kb < 8; ++kb) S[kb] = (f32x4){0.f, 0.f, 0.f, 0.f};
        u32x4 rqA[2], rkA[2], raA, rvA, rdA, rqB[2], rkB[2], raB, rvB, rdB, rqC[2], rkC[2], raC, rvC, rdC, rqD[2], rkD[2], raD, rvD, rdD;
#define G2_LOAD(nn_, rq, rk, ra, rv, rd) do { const int n_ = (nn_) < GNC ? (nn_) : GNC - 1; const size_t t0_ = (bh * SEQ + (n_) * 64) * 128; \
            _Pragma("unroll") for (int i_ = 0; i_ < 2; ++i_) { const int id_ = tid + 512 * i_; rq[i_] = *(const u32x4*)(gqt + t0_ + (size_t)id_ * 8); rk[i_] = *(const u32x4*)(gks + t0_ + (size_t)id_ * 8); } \
            ra = *(const u32x4*)(gatt + ((bh * GNC + (n_)) * 64) * 64 + (size_t)tid * 8); \
            rv = *(const u32x4*)(vg + ((size_t)(b * SEQ + (n_) * 64 + ((tid & 255) >> 2))) * 1024 + h * 256 + dvs * 32 + (tid & 3) * 8); \
            rd = *(const u32x4*)(gdec + ((bh * GNC + (n_)) * 128) + (tid & 31) * 4); } while (0)
#define G2_STORE(Lb, rq, rk, ra, rv, rd) do { _Pragma("unroll") for (int i_ = 0; i_ < 2; ++i_) { const int id_ = tid + 512 * i_; \
                *(LAS u32x4*)((Lb) + G2_QT + (id_ >> 4) * 272 + (id_ & 15) * 16) = rq[i_]; *(LAS u32x4*)((Lb) + G2_KS + (id_ >> 4) * 272 + (id_ & 15) * 16) = rk[i_]; } \
            *(LAS u32x4*)((Lb) + G2_ATT + (tid >> 3) * 144 + (tid & 7) * 16) = ra; \
            if (tid < 256) { *(LAS u32x2*)((Lb) + G2_V + (tid >> 2) * 72 + (tid & 3) * 16) = (u32x2){rv.x, rv.y}; *(LAS u32x2*)((Lb) + G2_V + (tid >> 2) * 72 + (tid & 3) * 16 + 8) = (u32x2){rv.z, rv.w}; } \
            if (tid < 32) *(LAS u32x4*)((Lb) + G2_DEC + tid * 16) = rd; } while (0)
#define G2_COMPUTE(n, Lb) do { \
            bf16x8 sf[4], vf[2]; \
            _Pragma("unroll") for (int ks = 0; ks < 4; ++ks) { u32x4 pk; pk.x = cvt_pk_bf16(S[2 * ks][0], S[2 * ks][1]); pk.y = cvt_pk_bf16(S[2 * ks][2], S[2 * ks][3]); \
                pk.z = cvt_pk_bf16(S[2 * ks + 1][0], S[2 * ks + 1][1]); pk.w = cvt_pk_bf16(S[2 * ks + 1][2], S[2 * ks + 1][3]); sf[ks] = __builtin_bit_cast(bf16x8, pk); } \
            _Pragma("unroll") for (int ks = 0; ks < 2; ++ks) { const LAS unsigned char* vp = (Lb) + G2_V + (32 * ks + 8 * g + q4) * 72 + (cw * 16 + 4 * p4) * 2; vf[ks] = cat8(ld_tr(vp), ld_tr(vp + 4 * 72)); } \
            _Pragma("unroll") for (int bb = 0; bb < 2; ++bb) { const int bi = 2 * rh + bb; f32x4 o = {0.f, 0.f, 0.f, 0.f}; \
                _Pragma("unroll") for (int ks = 0; ks < 2; ++ks) { const bf16x8 a = *(const LAS bf16x8*)((Lb) + G2_ATT + (bi * 16 + r) * 144 + (32 * ks + 8 * g) * 2); o = __builtin_amdgcn_mfma_f32_16x16x32_bf16(a, vf[ks], o, 0, 0, 0); } \
                _Pragma("unroll") for (int ks = 0; ks < 4; ++ks) { const LAS unsigned char* qp = (Lb) + G2_QT + (bi * 16 + r) * 272 + (32 * ks + 4 * g) * 2; \
                    const bf16x8 a = cat8(*(const LAS s16x4*)qp, *(const LAS s16x4*)(qp + 32)); o = __builtin_amdgcn_mfma_f32_16x16x32_bf16(a, sf[ks], o, 0, 0, 0); } \
                _Pragma("unroll") for (int rg = 0; rg < 4; ++rg) go[((size_t)(b * SEQ + (n) * 64 + bi * 16 + 4 * g + rg)) * 1024 + h * 256 + dvs * 32 + cw * 16 + r] = o[rg]; } \
            _Pragma("unroll") for (int kb = 0; kb < 8; ++kb) { const f32x4 dec = *(const LAS f32x4*)((Lb) + G2_DEC + (16 * kb + 4 * g) * 4); f32x4 nn = S[kb] * dec; \
                _Pragma("unroll") for (int ks = 0; ks < 2; ++ks) { const LAS unsigned char* kp = (Lb) + G2_KS + (32 * ks + 8 * g + q4) * 272 + (16 * kb + 4 * p4) * 2; \
                    nn = __builtin_amdgcn_mfma_f32_16x16x32_bf16(cat8(ld_tr(kp), ld_tr(kp + 4 * 272)), vf[ks], nn, 0, 0, 0); } \
                S[kb] = nn; } } while (0)
        G2_LOAD(0, rqA, rkA, raA, rvA, rdA); G2_LOAD(1, rqB, rkB, raB, rvB, rdB); G2_LOAD(2, rqC, rkC, raC, rvC, rdC); G2_LOAD(3, rqD, rkD, raD, rvD, rdD);
        G2_STORE(L, rqA, rkA, raA, rvA, rdA);
        for (int n = 0; n < GNC; n += 4) {
            __syncthreads(); G2_LOAD(n + 4, rqA, rkA, raA, rvA, rdA); G2_STORE(L + G2_BUF, rqB, rkB, raB, rvB, rdB); if (w < 4) G2_COMPUTE(n, L);
            __syncthreads(); G2_LOAD(n + 5, rqB, rkB, raB, rvB, rdB); G2_STORE(L, rqC, rkC, raC, rvC, rdC);          if (w < 4) G2_COMPUTE(n + 1, L + G2_BUF);
            __syncthreads(); G2_LOAD(n + 6, rqC, rkC, raC, rvC, rdC); G2_STORE(L + G2_BUF, rqD, rkD, raD, rvD, rdD); if (w < 4) G2_COMPUTE(n + 2, L);
            __syncthreads(); G2_LOAD(n + 7, rqD, rkD, raD, rvD, rdD); G2_STORE(L, rqA, rkA, raA, rvA, rdA);          if (w < 4) G2_COMPUTE(n + 3, L + G2_BUF);
        }
        __syncthreads();
#undef G2_LOAD
#undef G2_STORE
#undef G2_COMPUTE
    }
}
DI void gla_post(const Params& P, const Frame& F) {
    unsigned char* ws = P.ws; const float* go = (const float*)(ws + WS_GO); const bf16_t* rg = (const bf16_t*)(ws + WS_RG); bf16_t* og = (bf16_t*)(ws + WS_ONSA) + 1024; const float* gain = P.in[I_GLA_NORM];
    const int lane = F.lane;
    f32x4 gn[4];
#pragma unroll
    for (int i = 0; i < 4; ++i) gn[i] = *(const f32x4*)(gain + (i * 64 + lane) * 4);
    for (int tok = F.bid * 16 + F.wave * 2; tok < NTOK; tok += F.G * 16) {
        f32x4 v[2][4]; u32x2 rr[2][4];
#pragma unroll
        for (int t = 0; t < 2; ++t)
#pragma unroll
            for (int i = 0; i < 4; ++i) { const int c = (i * 64 + lane) * 4; v[t][i] = __builtin_nontemporal_load((const f32x4*)(go + (size_t)(tok + t) * 1024 + c)); rr[t][i] = *(const u32x2*)(rg + (size_t)(tok + t) * 1024 + c); }
        u32x2 o[2][4];
#pragma unroll
        for (int t = 0; t < 2; ++t)
#pragma unroll
            for (int i = 0; i < 4; ++i) {
                const f32x4 x = v[t][i]; float ss = x[0] * x[0] + x[1] * x[1] + x[2] * x[2] + x[3] * x[3]; ss = wave_sum(ss);
                const float rs = __builtin_amdgcn_rsqf(ss * (1.0f / 256.0f) + NORM_EPS);
                const float r0 = bflo(rr[t][i].x), r1 = bfhi(rr[t][i].x), r2 = bflo(rr[t][i].y), r3 = bfhi(rr[t][i].y);
                o[t][i].x = cvt_pk_bf16(x[0] * rs * gn[i][0] * r0 * fast_sigmoid(r0), x[1] * rs * gn[i][1] * r1 * fast_sigmoid(r1));
                o[t][i].y = cvt_pk_bf16(x[2] * rs * gn[i][2] * r2 * fast_sigmoid(r2), x[3] * rs * gn[i][3] * r3 * fast_sigmoid(r3)); }
#pragma unroll
        for (int t = 0; t < 2; ++t)
#pragma unroll
            for (int i = 0; i < 4; ++i) *(u32x2*)(og + (size_t)(tok + t) * 2048 + (i * 64 + lane) * 4) = o[t][i];
    }
}
constexpr int KSTR = 272, VSTR = 320;
constexpr int AT_K = 0, AT_V = 64 * KSTR, AT_BUF = 64 * KSTR + 64 * VSTR, AT_IMP = 2 * AT_BUF, AT_SELM = AT_IMP + 4 * 64 * 32 * 4, AT_END = AT_SELM + 512;
constexpr float AT_C2 = 0.08838834764831845f * 1.4426950408889634f;
DI float xmax32(float x) { auto rr = __builtin_amdgcn_permlane32_swap(__float_as_uint(x), __float_as_uint(x), false, false); return fmaxf(__uint_as_float(rr[0]), __uint_as_float(rr[1])); }
DI float xsum32(float x) { auto rr = __builtin_amdgcn_permlane32_swap(__float_as_uint(x), __float_as_uint(x), false, false); return __uint_as_float(rr[0]) + __uint_as_float(rr[1]); }
DI float xget32(float x, int hi) { auto rr = __builtin_amdgcn_permlane32_swap(__float_as_uint(x), __float_as_uint(x), false, false); return __uint_as_float(hi ? rr[0] : rr[1]); }
#define MFMA32(a, b, c) __builtin_amdgcn_mfma_f32_32x32x16_bf16((a), (b), (c), 0, 0, 0)

DI void at_load(u32x4 (&rk)[2], u32x4 (&rv)[2], const bf16_t* Kb, const bf16_t* Vb, int key0, int tid) {
#pragma unroll
    for (int i = 0; i < 2; ++i) { const size_t o = (size_t)key0 * 128 + (size_t)(tid + 512 * i) * 8; rk[i] = *(const u32x4*)(Kb + o); rv[i] = *(const u32x4*)(Vb + o); }
}
DI void at_store(LAS unsigned char* L, const u32x4 (&rk)[2], const u32x4 (&rv)[2], int tid) {
#pragma unroll
    for (int i = 0; i < 2; ++i) { const int id = tid + 512 * i; *(LAS u32x4*)(L + AT_K + (id >> 4) * KSTR + (id & 15) * 16) = rk[i]; *(LAS u32x4*)(L + AT_V + (id >> 4) * VSTR + (id & 15) * 16) = rv[i]; }
}
DI void at_qk(f32x16& p0, f32x16& p1, const LAS unsigned char* L, const bf16x8 (&qr)[8], int r32, int hi) {
#pragma unroll
    for (int r = 0; r < 16; ++r) { p0[r] = 0.f; p1[r] = 0.f; }
    const LAS unsigned char* kb = L + AT_K + r32 * KSTR + hi * 16;
#pragma unroll
    for (int ks = 0; ks < 8; ++ks) {
        const bf16x8 a0 = *(const LAS bf16x8*)(kb + ks * 32), a1 = *(const LAS bf16x8*)(kb + 32 * KSTR + ks * 32);
        p0 = MFMA32(a0, qr[ks], p0); p1 = MFMA32(a1, qr[ks], p1);
    }
}
DI bf16x8 at_pack(const f32x16& x, const int s) {
    u32x4 w; w.x = cvt_pk_bf16(x[8 * s + 0], x[8 * s + 1]); w.y = cvt_pk_bf16(x[8 * s + 2], x[8 * s + 3]); w.z = cvt_pk_bf16(x[8 * s + 4], x[8 * s + 5]); w.w = cvt_pk_bf16(x[8 * s + 6], x[8 * s + 7]);
    return __builtin_bit_cast(bf16x8, w);
}
DI void at_pv(f32x16 (&o)[4], const LAS unsigned char* L, const f32x16& p0, const f32x16& p1, int lane) {
    const int hi = lane >> 5, q4 = (lane & 15) >> 2, p4 = lane & 3;
    const LAS unsigned char* vb = L + AT_V + (4 * hi + q4) * VSTR + (16 * ((lane >> 4) & 1) + 4 * p4) * 2;
#pragma unroll
    for (int s = 0; s < 4; ++s) {
        const bf16x8 pf = (s < 2) ? at_pack(p0, s & 1) : at_pack(p1, s & 1);
#pragma unroll
        for (int nb = 0; nb < 4; ++nb) {
            const s16x4 lo = ld_tr(vb + (16 * s) * VSTR + nb * 64), h8 = ld_tr(vb + (16 * s + 8) * VSTR + nb * 64);
            o[nb] = MFMA32(cat8(lo, h8), pf, o[nb]);
        }
    }
}
DI float at_softmax(f32x16& p0, f32x16& p1, float& m, float& l, f32x16 (&o)[4], bool dead = false) {
    float pmax = p0[0];
#pragma unroll
    for (int r = 1; r < 16; ++r) pmax = fmaxf(pmax, p0[r]);
#pragma unroll
    for (int r = 0; r < 16; ++r) pmax = fmaxf(pmax, p1[r]);
    pmax = xmax32(pmax); pmax = dead ? -__builtin_inff() : pmax;
    const bool keep = __all((pmax - m) * AT_C2 <= 11.5f);
    const float mn = keep ? m : fmaxf(m, pmax), alpha = keep ? 1.0f : __builtin_amdgcn_exp2f((m - mn) * AT_C2), mnl = dead ? __builtin_inff() : mn * AT_C2; m = mn;
    float ps = 0.f;
#pragma unroll
    for (int r = 0; r < 16; ++r) { p0[r] = __builtin_amdgcn_exp2f(fmaf(p0[r], AT_C2, -mnl)); p1[r] = __builtin_amdgcn_exp2f(fmaf(p1[r], AT_C2, -mnl)); ps += p0[r] + p1[r]; }
    ps = xsum32(ps);
    l = l * alpha + ps;
    if (__any(alpha < 1.0f)) {
#pragma unroll
        for (int nb = 0; nb < 4; ++nb)
#pragma unroll
            for (int r = 0; r < 16; ++r) o[nb][r] *= alpha;
    }
    return alpha;
}
DI int at_crow(int r, int hi) { return (r & 3) + 8 * (r >> 2) + 4 * hi; }
constexpr int AT_STG = 0, STG_STR = 144, STG_WAVE = 32 * STG_STR;
DI void at_flush(bf16_t* orow0, LAS unsigned char* stg, const f32x16 (&o)[4], float scale, bool first, int lane) {
    const int r32 = lane & 31, hi = lane >> 5;
#pragma unroll
    for (int half = 0; half < 2; ++half) {
#pragma unroll
        for (int nn = 0; nn < 2; ++nn)
#pragma unroll
            for (int gq = 0; gq < 4; ++gq) { const int nb = 2 * half + nn;
                u32x2 v; v.x = cvt_pk_bf16(o[nb][4 * gq] * scale, o[nb][4 * gq + 1] * scale); v.y = cvt_pk_bf16(o[nb][4 * gq + 2] * scale, o[nb][4 * gq + 3] * scale);
                *(LAS u32x2*)(stg + r32 * STG_STR + (nn * 32 + 8 * gq + 4 * hi) * 2) = v; }
#pragma unroll
        for (int it = 0; it < 4; ++it) { const int row = it * 8 + (lane >> 3), ch = lane & 7;
            u32x4 s = *(const LAS u32x4*)(stg + row * STG_STR + ch * 16);
            bf16_t* gp = orow0 + (size_t)row * 2048 + half * 64 + ch * 8;
            if (!first) { const u32x4 t = *(const u32x4*)gp;
                s.x = cvt_pk_bf16(bflo(s.x) + bflo(t.x), bfhi(s.x) + bfhi(t.x)); s.y = cvt_pk_bf16(bflo(s.y) + bflo(t.y), bfhi(s.y) + bfhi(t.y));
                s.z = cvt_pk_bf16(bflo(s.z) + bflo(t.z), bfhi(s.z) + bfhi(t.z)); s.w = cvt_pk_bf16(bflo(s.w) + bflo(t.w), bfhi(s.w) + bfhi(t.w)); }
            *(u32x4*)gp = s; }
    }
}
DI void at_blocksums(const f32x16& p0, const f32x16& p1, int hi, float carry_in, float (&bs)[8], float& carry_out) {
    float lastv[8];
#pragma unroll
    for (int gq = 0; gq < 4; ++gq) {
        bs[gq] = (p0[4 * gq] + p0[4 * gq + 1]) + (p0[4 * gq + 2] + p0[4 * gq + 3]); lastv[gq] = p0[4 * gq + 3];
        bs[4 + gq] = (p1[4 * gq] + p1[4 * gq + 1]) + (p1[4 * gq + 2] + p1[4 * gq + 3]); lastv[4 + gq] = p1[4 * gq + 3];
    }
    float xs[8];
#pragma unroll
    for (int gi = 0; gi < 8; ++gi) xs[gi] = xget32(lastv[gi], hi);
#pragma unroll
    for (int gi = 0; gi < 8; ++gi) bs[gi] += hi ? xs[gi] : (gi > 0 ? xs[gi > 0 ? gi - 1 : 0] : carry_in);
    carry_out = xs[7];
}
DI void nsa_unit(const Params& P, const Frame& F, int b, int g, int tb) {
    unsigned char* ws = P.ws; LAS unsigned char* L = F.lds;
    int tid = threadIdx.x; asm volatile("" : "+v"(tid));
    const int lane = tid & 63, w = F.wave, r32 = lane & 31, hi = lane >> 5, hp = w >> 1;
    const int qi = (w & 1) * 32 + r32, q0 = tb * 64, pos = q0 + qi, tok = b * SEQ + pos, bg = b * 2 + g, head = g * 4 + hp;
    LAS float* imp = (LAS float*)(L + AT_IMP); LAS unsigned* selm = (LAS unsigned*)(L + AT_SELM);
    const float* gl = (const float*)(ws + WS_SMALL) + (size_t)tok * 64 + head * 3;
    const float g_cmp = fast_sigmoid(gl[0]), g_sel = fast_sigmoid(gl[1]), g_win = fast_sigmoid(gl[2]);
    bf16_t* const orow0 = (bf16_t*)(ws + WS_ONSA) + (size_t)(b * SEQ + q0 + (w & 1) * 32) * 2048 + head * 128;
    LAS unsigned char* const stg = L + AT_STG + w * STG_WAVE;
    bf16x8 qr[8];
    u32x4 rk[2], rv[2];
    f32x16 o[4], p0, p1;
    {
        const bf16_t* qp = (const bf16_t*)(ws + WS_QRAW) + (size_t)tok * 1024 + head * 128 + hi * 8;
#pragma unroll
        for (int ks = 0; ks < 8; ++ks) qr[ks] = *(const bf16x8*)(qp + ks * 16);
        const bf16_t* Kb = (const bf16_t*)(ws + WS_KCMP) + (size_t)bg * 128 * 128; const bf16_t* Vb = Kb + (size_t)16 * 128 * 128;
        int nmax = pos >= 31 ? ((pos - 31) >> 4) : -1;
#pragma unroll
        for (int nb = 0; nb < 4; ++nb)
#pragma unroll
            for (int r = 0; r < 16; ++r) o[nb][r] = 0.f;
        float m = -1e30f, l = 0.f;
        float bs0[8], bs1[8], carry0, carry1;
        if (tid < 64) selm[tid] = 0u;
        at_load(rk, rv, Kb, Vb, 0, tid);
        __syncthreads(); at_store(L, rk, rv, tid);
        at_load(rk, rv, Kb, Vb, 64, tid);
        __syncthreads(); at_store(L + AT_BUF, rk, rv, tid);
        at_qk(p0, p1, L, qr, r32, hi);
        asm volatile("" : "+v"(nmax));
#pragma unroll
        for (int r = 0; r < 16; ++r) { const int n = at_crow(r, hi); if (n > nmax) p0[r] = -__builtin_inff(); if (n + 32 > nmax) p1[r] = -__builtin_inff(); }
        at_softmax(p0, p1, m, l, o);
        at_pv(o, L, p0, p1, lane);
        at_blocksums(p0, p1, hi, 0.f, bs0, carry0);
        __syncthreads();
        at_qk(p0, p1, L + AT_BUF, qr, r32, hi);
        asm volatile("" : "+v"(nmax));
#pragma unroll
        for (int r = 0; r < 16; ++r) { const int n = 64 + at_crow(r, hi); if (n > nmax) p0[r] = -__builtin_inff(); if (n + 32 > nmax) p1[r] = -__builtin_inff(); }
        const float al1 = at_softmax(p0, p1, m, l, o);
        at_pv(o, L + AT_BUF, p0, p1, lane);
        at_blocksums(p0, p1, hi, carry0 * al1, bs1, carry1);
        const float inv = l > 0.f ? 1.0f / l : 0.f;
        __syncthreads();
        at_flush(orow0, stg, o, inv * g_cmp, true, lane);
        {
            const float f0 = al1 * inv, f1 = inv;
            int ib = (hp * 64 + qi) * 32 + hi; asm volatile("" : "+v"(ib));
#pragma unroll
            for (int gi = 0; gi < 8; ++gi) { imp[ib + 2 * gi] = bs0[gi] * f0; imp[ib + 16 + 2 * gi] = bs1[gi] * f1; }
        }
        __syncthreads();
        {
            LAS float* totl = (LAS float*)(L + AT_BUF + AT_V);
            int tid2 = threadIdx.x; asm volatile("" : "+v"(tid2));
#pragma unroll
            for (int q = 0; q < 4; ++q) { const int idx = tid2 + 512 * q, qq = idx >> 5, j = idx & 31;
                float sv = (imp[(0 * 64 + qq) * 32 + j] + imp[(1 * 64 + qq) * 32 + j]) + (imp[(2 * 64 + qq) * 32 + j] + imp[(3 * 64 + qq) * 32 + j]);
                sv += (j > tb) ? -1000.0f : ((j == 0 || j == tb || j == tb - 1) ? 1000.0f : 0.0f); totl[idx] = sv; }
            __syncthreads();
            const int qq = tid2 >> 3, sub = tid2 & 7; float v[32];
#pragma unroll
            for (int j = 0; j < 32; ++j) v[j] = totl[qq * 32 + j];
            unsigned bits = 0u;
#pragma unroll 1
            for (int jj = 0; jj < 4; ++jj) {
                const int j = sub * 4 + jj; const float vj = totl[qq * 32 + j];
                int rank = 0;
#pragma unroll
                for (int i = 0; i < 32; ++i) rank += (v[i] > vj || (v[i] == vj && i < j)) ? 1 : 0;
                if (rank < 16) bits |= 1u << j;
            }
            if (bits) __hip_atomic_fetch_or((LAS unsigned*)&selm[qq], bits, __ATOMIC_RELAXED, __HIP_MEMORY_SCOPE_WORKGROUP);
        }
        __syncthreads();
    }
    {
        const bf16_t* qp = (const bf16_t*)(ws + WS_QRAW) + (size_t)tok * 1024 + head * 128 + hi * 8;
        const f32x4* tp = (const f32x4*)((const f32x2*)(ws + WS_TAB) + (size_t)pos * 64 + hi * 8);
#pragma unroll
        for (int ks = 0; ks < 4; ++ks) {
            const u32x4 lo = *(const u32x4*)(qp + ks * 16), hh = *(const u32x4*)(qp + 64 + ks * 16);
            const f32x4 c01 = tp[ks * 8 + 0], c23 = tp[ks * 8 + 1], c45 = tp[ks * 8 + 2], c67 = tp[ks * 8 + 3];
            u32x4 ol, oh;
            { const float a0 = bflo(lo.x), a1 = bfhi(lo.x), b0 = bflo(hh.x), b1 = bfhi(hh.x); ol.x = cvt_pk_bf16(a0 * c01[0] - b0 * c01[1], a1 * c01[2] - b1 * c01[3]); oh.x = cvt_pk_bf16(b0 * c01[0] + a0 * c01[1], b1 * c01[2] + a1 * c01[3]); }
            { const float a0 = bflo(lo.y), a1 = bfhi(lo.y), b0 = bflo(hh.y), b1 = bfhi(hh.y); ol.y = cvt_pk_bf16(a0 * c23[0] - b0 * c23[1], a1 * c23[2] - b1 * c23[3]); oh.y = cvt_pk_bf16(b0 * c23[0] + a0 * c23[1], b1 * c23[2] + a1 * c23[3]); }
            { const float a0 = bflo(lo.z), a1 = bfhi(lo.z), b0 = bflo(hh.z), b1 = bfhi(hh.z); ol.z = cvt_pk_bf16(a0 * c45[0] - b0 * c45[1], a1 * c45[2] - b1 * c45[3]); oh.z = cvt_pk_bf16(b0 * c45[0] + a0 * c45[1], b1 * c45[2] + a1 * c45[3]); }
            { const float a0 = bflo(lo.w), a1 = bfhi(lo.w), b0 = bflo(hh.w), b1 = bfhi(hh.w); ol.w = cvt_pk_bf16(a0 * c67[0] - b0 * c67[1], a1 * c67[2] - b1 * c67[3]); oh.w = cvt_pk_bf16(b0 * c67[0] + a0 * c67[1], b1 * c67[2] + a1 * c67[3]); }
            qr[ks] = __builtin_bit_cast(bf16x8, ol); qr[ks + 4] = __builtin_bit_cast(bf16x8, oh);
        }
    }
    const unsigned mysel = selm[qi];
    unsigned uni = 0u;
    { unsigned u0 = selm[lane];
#pragma unroll
      for (int o_ = 32; o_ > 0; o_ >>= 1) u0 |= __shfl_xor(u0, o_);
      uni = __builtin_amdgcn_readfirstlane(u0); }
#pragma unroll 1
    for (int br = 0; br < 2; ++br) {
        const bf16_t* Kb = (const bf16_t*)(ws + WS_KV + (size_t)(br == 0 ? 2 : 4) * KV_STRIDE) + (size_t)bg * SEQ * 128;
        const bf16_t* Vb = (const bf16_t*)(ws + WS_KV + (size_t)(br == 0 ? 3 : 5) * KV_STRIDE) + (size_t)bg * SEQ * 128;
        unsigned tl = (br == 0) ? (uni & (tb == 31 ? 0xffffffffu : ((2u << tb) - 1u))) : ((tb == 31 ? 0xffffffffu : ((2u << tb) - 1u)) & ~(tb >= 9 ? ((1u << (tb - 8)) - 1u) : 0u));
#pragma unroll
        for (int nb = 0; nb < 4; ++nb)
#pragma unroll
            for (int r = 0; r < 16; ++r) o[nb][r] = 0.f;
        float m = -1e30f, l = 0.f;
        int j = __builtin_ctz(tl); tl &= tl - 1u;
        at_load(rk, rv, Kb, Vb, j * 64, tid);
        __syncthreads();
        at_store(L, rk, rv, tid);
        int jn = tl ? __builtin_ctz(tl) : -1; tl &= tl - 1u;
        if (jn >= 0) at_load(rk, rv, Kb, Vb, jn * 64, tid);
        int cur = 0;
        for (;;) {
            __syncthreads();
            const LAS unsigned char* Lb = L + cur * AT_BUF;
            if (jn >= 0) {
                at_store(L + (cur ^ 1) * AT_BUF, rk, rv, tid);
                const int jnn = tl ? __builtin_ctz(tl) : -1;
                if (jnn >= 0) at_load(rk, rv, Kb, Vb, jnn * 64, tid);
            }
            at_qk(p0, p1, Lb, qr, r32, hi);
            int qim = qi; asm volatile("" : "+v"(qim));
            bool dead = false;
            if (br == 0) {
                dead = !((mysel >> j) & 1u);
                if (j == tb) {
#pragma unroll
                    for (int r = 0; r < 16; ++r) { const int kr = at_crow(r, hi); if (kr > qim) p0[r] = -__builtin_inff(); if (kr + 32 > qim) p1[r] = -__builtin_inff(); }
                }
            } else {
                if (j == tb) {
#pragma unroll
                    for (int r = 0; r < 16; ++r) { const int kr = at_crow(r, hi); if (kr > qim) p0[r] = -__builtin_inff(); if (kr + 32 > qim) p1[r] = -__builtin_inff(); }
                } else if (j == tb - 8) {
#pragma unroll
                    for (int r = 0; r < 16; ++r) { const int kr = at_crow(r, hi); if (kr <= qim) p0[r] = -__builtin_inff(); if (kr + 32 <= qim) p1[r] = -__builtin_inff(); }
                }
            }
            at_softmax(p0, p1, m, l, o, dead);
            at_pv(o, Lb, p0, p1, lane);
            if (jn < 0) break;
            j = jn; jn = tl ? __builtin_ctz(tl) : -1; tl &= tl - 1u; cur ^= 1;
        }
        __syncthreads();
        at_flush(orow0, stg, o, (br == 0 ? g_sel : g_win) / l, false, lane);
    }
    __syncthreads();
}
DI void nsa_phase(const Params& P, const Frame& F) {
    for (int it = F.bid; it < 256; it += F.G) {
        const int bgi = it >> 4, pr = it & 15;
#pragma unroll 1
        for (int u = 0; u < 2; ++u) nsa_unit(P, F, bgi >> 1, bgi & 1, u ? pr : 31 - pr);
    }
}
__global__ void __launch_bounds__(512, 2) fwd(Params P) {
    extern __shared__ __attribute__((aligned(16))) unsigned char lds_raw[];
    Frame F; F.lds = (LAS unsigned char*)lds_raw; F.tid = threadIdx.x; F.lane = F.tid & 63; F.wave = __builtin_amdgcn_readfirstlane(F.tid >> 6); F.G = gridDim.x; F.bid = blockIdx.x;
    F.ctl = (unsigned*)(P.ws + WS_CTL);
    volatile LAS unsigned* misc = (volatile LAS unsigned*)(F.lds + LDS_MISC);
    if (F.tid < 64) misc[F.tid] = 0u;
    __syncthreads();
    XcdBarrier bar = xcd_barrier_post(F.ctl + CW_BAR, misc + 8);
    unsigned char* ws = P.ws;
#define FRESH(FN) Frame FN = F; { int t_ = threadIdx.x; asm volatile("" : "+v"(t_)); FN.tid = t_; FN.lane = t_ & 63; }
    LAS int* tb = (LAS int*)(F.lds + LDS_TAB);

    { FRESH(Fp); p0_prologue(P, Fp); }
    xcd_barrier(bar);
#ifdef SPLIT_CONV
    constexpr int CONV_PER64 = SPLIT_CONV, CONV_TAIL = SPLIT_TAIL;
    const bool split = (F.G & 63) == 0;
    if (split && (F.bid & 63) >= 64 - CONV_PER64) {
        FRESH(Fp); Fp.G = (F.G >> 6) * CONV_PER64; Fp.bid = (F.bid >> 6) * CONV_PER64 + ((F.bid & 63) - (64 - CONV_PER64));
        cvt8_range(P, Fp, 0, CVT8_DN - CONV_TAIL);
    } else
#endif
    {
#ifdef SPLIT_CONV
        const int Gg = split ? (F.G >> 6) * (64 - CONV_PER64) : F.G, cg = split ? (F.bid >> 6) * (64 - CONV_PER64) + (F.bid & 63) : F.bid;
#else
        const int Gg = F.G, cg = F.bid;
#endif
        SchedStd Sa{(const char*)(ws + WS_HN), (const char*)(ws + WS_WT1), 4096u, 4096u, 64, N1A_TILES, Gg, cg};
        Epi1<false> Ea{ws, P.in[I_BMG], F.lds};
        pg8::gemm_phase<false>(F.lds, 2048, 4096u, Sa, Ea);
        Epi1<true> Eb{ws, P.in[I_BMG], F.lds};
        if (split && Gg == 160) {
            SchedStdB Sb{(const char*)(ws + WS_HN8), (const char*)(ws + WS_WT1B), 2048u, 2048u, 64, N1B_TILES, Gg, cg};
            pg8::gemm_phase<true>(F.lds, 1024, 2048u, Sb, Eb);
        } else {
            SchedStd Sb{(const char*)(ws + WS_HN8), (const char*)(ws + WS_WT1B), 2048u, 2048u, 64, N1B_TILES, Gg, cg};
            pg8::gemm_phase<true>(F.lds, 1024, 2048u, Sb, Eb);
        }
#ifdef SPLIT_CONV
        if (split && Gg == 160) {
            constexpr int CONV_BIAS = 10;
            if (cg >= 32 && cg < 64) { FRESH(Fp); Fp.G = 32; Fp.bid = cg - 32; cvt8_range(P, Fp, CVT8_DN - CONV_TAIL, CVT8_DN - CONV_TAIL + 32 * CONV_BIAS); }
            { FRESH(Fp); Fp.G = Gg; Fp.bid = cg; cvt8_range(P, Fp, CVT8_DN - CONV_TAIL + 32 * CONV_BIAS, CVT8_DN); }
        } else { FRESH(Fp); if (split) { Fp.G = Gg; Fp.bid = cg; cvt8_range(P, Fp, CVT8_DN - CONV_TAIL, CVT8_DN); } else cvt8_range(P, Fp, 0, CVT8_DN); }
#endif
    }
    xcd_barrier(bar);
    {
        EpiCmp E{(bf16_t*)(ws + WS_CPART)};
        for (int base = 0; base < 256; base += F.G) { SchedCmp S{ws, F.G, base + F.bid}; pg8::gemm_phase<false>(F.lds, 256, 8192u, S, E); }
        { FRESH(Fp); gla_prep(P, Fp); }
    }
    xcd_barrier(bar);
    { FRESH(Fp); cmp_stage2(P, Fp); }
    { FRESH(Fp); gla_scan(P, Fp); }
    xcd_barrier(bar);
    { FRESH(Fp); nsa_phase(P, Fp); }
    { FRESH(Fp); gla_post(P, Fp); }
    xcd_barrier(bar);
    {
        SchedProj S{(const char*)(ws + WS_ONSA), (const char*)(ws + WS_WPN), F.G, F.bid};
        EpiProjF E{ws};
        pg8::gemm_phase<false>(F.lds, 1024, 4096u, S, E);
    }
    xcd_barrier(bar);
    {
        SchedStd S{(const char*)(ws + WS_MIXED), (const char*)(ws + WS_WOUT), 4096u, 4096u, 64, 8, F.G, F.bid};
        EpiOut E{P.in[I_X], (bf16_t*)(ws + WS_X2), (float*)(ws + WS_SSQP)};
        pg8::gemm_phase<false>(F.lds, 2048, 4096u, S, E);
    }
    xcd_barrier(bar);
    { FRESH(Fp); p7_router(P, Fp); }
    xcd_barrier(bar);
    { FRESH(Fp); moe_table(Fp); }
    {
        SchedGU S{(const char*)(ws + WS_HN2), (const char*)(ws + WS_WGU), (const int*)(ws + WS_STOK), tb, F.G, F.bid};
        EpiGU E{ws + WS_ACT, P.in[I_BGU], F.lds};
        pg8::gemm_phase<true>(F.lds, 1024, 2048u, S, E);
    }
    xcd_barrier(bar);
    {
        SchedDN S{(const char*)(ws + WS_ACT), (const char*)(ws + WS_WDN), tb, F.G, F.bid};
        EpiDN E{ws + WS_EO, P.in[I_BDN], F.lds};
        pg8::gemm_phase<true>(F.lds, 1024, 2048u, S, E);
    }
    xcd_barrier(bar);
    { FRESH(Fp); p10_final(P, Fp); }
}
extern "C" void kernel_launch(void* const* d_in, const int* in_sizes, int n_in, void* d_out, int out_size, void* d_ws, size_t ws_size, hipStream_t stream) {
    static int grid = 0;
    if (grid == 0) {
        if (n_in != 25 || out_size != NTOK * DM || ws_size < WS_END) { fprintf(stderr, "kernel_launch: unexpected shapes n_in %d out %d ws %zu\n", n_in, out_size, ws_size); grid = -1; return; }
        int dev = 0, cus = 0, per_cu = 0;
        if (hipGetDevice(&dev) != hipSuccess || hipDeviceGetAttribute(&cus, hipDeviceAttributeMultiprocessorCount, dev) != hipSuccess) { grid = -1; return; }
        if (hipFuncSetAttribute((const void*)fwd, hipFuncAttributeMaxDynamicSharedMemorySize, LDS_BYTES) != hipSuccess) { fprintf(stderr, "kernel_launch: hipFuncSetAttribute failed\n"); grid = -1; return; }
        if (hipOccupancyMaxActiveBlocksPerMultiprocessor(&per_cu, (const void*)fwd, 512, LDS_BYTES) != hipSuccess || per_cu < 1) { fprintf(stderr, "kernel_launch: occupancy query says %d\n", per_cu); }
        (void)hipGetLastError();
        grid = cus;
    }
    if (grid < 0) return;
    if (hipMemsetAsync((char*)d_ws + WS_CTL, 0, CTL_ZERO_BYTES, stream) != hipSuccess) return;
    Params p{};
    for (int i = 0; i < 25; ++i) p.in[i] = (const float*)d_in[i];
    p.out = (float*)d_out; p.ws = (unsigned char*)d_ws; p.rope_r = pow(10000.0, -1.0 / 64.0);
    hipLaunchKernelGGL(fwd, dim3(grid), dim3(512), LDS_BYTES, stream, p);
}
```
